# Optimizing an MI355X kernel written in HIP

```python
import math
import jax, jax.numpy as jnp
from jax import lax
import numpy as np

D_MODEL = 2048
BATCH = 2
SEQ = 8192
DEPTH = 2

D_FF = 5632
NORM_EPS = 1e-6

W_LRU = 1024
LRU_HEADS = 8
LRU_BLOCK = W_LRU // LRU_HEADS
CONV_W = 4
CONV_PAD_L = 2
LRU_C = 8.0

W_MLSTM = 1024
MLSTM_HEADS = 4
MLSTM_DH = W_MLSTM // MLSTM_HEADS
MLSTM_CHUNK = 64

AB_SPLITS = (W_LRU, W_LRU, W_MLSTM, W_MLSTM, W_MLSTM, W_MLSTM, 4 * MLSTM_HEADS)
AB_IN = 2 * W_LRU + 4 * W_MLSTM + 4 * MLSTM_HEADS

GLA_HEADS = 4
GLA_DK = 128
GLA_DV = 256
GLA_QK = GLA_HEADS * GLA_DK
GLA_V = GLA_HEADS * GLA_DV
GLA_RANK = 16
GLA_TAU = 16.0
GLA_CHUNK = 64

S5_W = 1024
S5_GROUP = 16
S5_GROUPS = S5_W // S5_GROUP
S5_P = 64
S5_DT_MIN = 0.001
S5_DT_MAX = 0.1

CD_SPLITS = (GLA_QK, GLA_QK, GLA_V, GLA_V, 2 * GLA_RANK, S5_W)
CD_IN = 2 * GLA_QK + 2 * GLA_V + 2 * GLA_RANK + S5_W

MIX_OUT = W_LRU + W_MLSTM

kernel_name = 'hybrid_bidir_rglru_mlstm_gla_s5_macaron'


def _split(t, sizes):
    bounds = [int(b) for b in np.cumsum(sizes)[:-1]]
    return jnp.split(t, bounds, axis=-1)


def rms_norm(x, g):
    xf = x.astype(jnp.float32)
    y = xf * lax.rsqrt(jnp.mean(xf * xf, axis=-1, keepdims=True) + NORM_EPS)
    return (y * g.astype(jnp.float32)).astype(x.dtype)


def headwise_rms_norm(t, g):
    y = t * lax.rsqrt(jnp.mean(t * t, axis=-1, keepdims=True) + NORM_EPS)
    return y.reshape(t.shape[:2] + (-1,)) * g


def swiglu(h, w_gu, w_down):
    g, u = jnp.split(h @ w_gu, 2, axis=-1)
    return (jax.nn.silu(g) * u) @ w_down


def _heads(t, n):
    return t.reshape(t.shape[:2] + (n, -1)).transpose(0, 2, 1, 3)


def _flip_seq(t):
    return jnp.flip(t, axis=2)


def _to_chunks(t, chunk):
    b, h, s = t.shape[:3]
    t = t.reshape((b, h, s // chunk, chunk) + t.shape[3:])
    return jnp.moveaxis(t, 2, 0)


def _from_chunks(t):
    nc, b, h, l = t.shape[:4]
    return jnp.moveaxis(t, 0, 2).reshape((b, h, nc * l) + t.shape[4:])


def _affine_combine(e1, e2):
    a1, b1 = e1
    a2, b2 = e2
    return a1 * a2, a2 * b1 + b2


def _complex_affine_combine(e1, e2):
    a1r, a1i, b1r, b1i = e1
    a2r, a2i, b2r, b2i = e2
    ar = a1r * a2r - a1i * a2i
    ai = a1r * a2i + a1i * a2r
    br = a2r * b1r - a2i * b1i + b2r
    bi = a2r * b1i + a2i * b1r + b2i
    return ar, ai, br, bi


def centred_depthwise_conv(x, w, b):
    c = x.shape[-1]
    y = lax.conv_general_dilated(
        x, w[:, None, :].astype(x.dtype), window_strides=(1,),
        padding=[(CONV_PAD_L, CONV_W - 1 - CONV_PAD_L)],
        dimension_numbers=('NWC', 'WIO', 'NWC'), feature_group_count=c)
    return y + b


def block_diag_linear(x, w, b):
    xh = x.reshape(x.shape[:2] + (LRU_HEADS, LRU_BLOCK))
    return jnp.einsum('bshi,hij->bshj', xh, w).reshape(x.shape) + b


def rg_lru_direction(x, w_r, b_r, w_i, b_i, lam, reverse):
    r = jax.nn.sigmoid(block_diag_linear(x, w_r, b_r))
    i = jax.nn.sigmoid(block_diag_linear(x, w_i, b_i))
    log_a = -LRU_C * r * jax.nn.softplus(-lam)
    a = jnp.exp(log_a)
    b = jnp.sqrt(-jnp.expm1(2.0 * log_a)) * (i * x)
    _, h = lax.associative_scan(_affine_combine, (a, b), axis=1, reverse=reverse)
    return h


def mlstm_chunkwise(q, k, v, ig, lf):
    bsz, nh, _, dh = q.shape
    L = MLSTM_CHUNK
    mask = jnp.tril(jnp.ones((L, L), dtype=bool))
    xs = tuple(_to_chunks(t, L) for t in (q, k, v, ig, lf))

    def step(carry, inp):
        c_st, n_st, m_st = carry
        qt, kt, vt, it, ft = inp
        cum = jnp.cumsum(ft, axis=-1)
        dmat = jnp.where(mask, cum[..., :, None] - cum[..., None, :] + it[..., None, :], -jnp.inf)
        m_inter = cum + m_st[..., None]
        m_t = jnp.maximum(jnp.max(dmat, axis=-1), m_inter)
        w_intra = jnp.exp(dmat - m_t[..., None])
        w_inter = jnp.exp(m_inter - m_t)
        s = jnp.einsum('bhtd,bhsd->bhts', qt, kt) * w_intra
        num = jnp.einsum('bhts,bhse->bhte', s, vt) + w_inter[..., None] * jnp.einsum('bhtd,bhde->bhte', qt, c_st)
        den = jnp.sum(s, axis=-1) + w_inter * jnp.einsum('bhtd,bhd->bht', qt, n_st)
        h = num / jnp.maximum(jnp.abs(den), jnp.exp(-m_t))[..., None]
        tot = cum[..., -1]
        dec_s = tot[..., None] - cum + it
        m_new = jnp.maximum(tot + m_st, jnp.max(dec_s, axis=-1))
        ws = jnp.exp(dec_s - m_new[..., None])
        wc = jnp.exp(tot + m_st - m_new)
        c_new = wc[..., None, None] * c_st + jnp.einsum('bhs,bhsd,bhse->bhde', ws, kt, vt)
        n_new = wc[..., None] * n_st + jnp.einsum('bhs,bhsd->bhd', ws, kt)
        return (c_new, n_new, m_new), h

    init = (jnp.zeros((bsz, nh, dh, dh), q.dtype), jnp.zeros((bsz, nh, dh), q.dtype),
            jnp.zeros((bsz, nh), q.dtype))
    _, hs = lax.scan(step, init, xs)
    return _from_chunks(hs)


def mixer_ab(h, w_in, conv_w, conv_b, lru_gate_w, lru_gate_b, lru_lambda, mlstm_gate_b, mlstm_norm, w_out):
    bsz, s, _ = h.shape
    proj = (h @ w_in).astype(jnp.float32)
    xr, gr, q, k, v, o, gates = _split(proj, AB_SPLITS)
    xr = centred_depthwise_conv(xr, conv_w, conv_b)
    h_lru = (rg_lru_direction(xr, lru_gate_w[0, 0], lru_gate_b[0, 0], lru_gate_w[0, 1], lru_gate_b[0, 1],
                              lru_lambda[0], False)
             + rg_lru_direction(xr, lru_gate_w[1, 0], lru_gate_b[1, 0], lru_gate_w[1, 1], lru_gate_b[1, 1],
                                lru_lambda[1], True))
    y_a = jax.nn.gelu(gr) * h_lru
    q = _heads(q, MLSTM_HEADS) * (MLSTM_DH ** -0.5)
    k = _heads(k, MLSTM_HEADS)
    v = _heads(v, MLSTM_HEADS)
    g = (gates.reshape(bsz, s, 2, 2, MLSTM_HEADS) + mlstm_gate_b).transpose(2, 3, 0, 4, 1)
    h_f = mlstm_chunkwise(q, k, v, g[0, 0], jax.nn.log_sigmoid(g[0, 1]))
    h_b = _flip_seq(mlstm_chunkwise(_flip_seq(q), _flip_seq(k), _flip_seq(v), _flip_seq(g[1, 0]),
                                    _flip_seq(jax.nn.log_sigmoid(g[1, 1]))))
    hm = headwise_rms_norm((h_f + h_b).transpose(0, 2, 1, 3), mlstm_norm)
    y_b = jax.nn.sigmoid(o) * hm
    y = jnp.concatenate([y_a, y_b], axis=-1)
    return y.astype(h.dtype) @ w_out


def gla_chunked(q, k, v, la):
    bsz, nh, _, dk = q.shape
    dv = v.shape[-1]
    L = GLA_CHUNK
    mask = jnp.tril(jnp.ones((L, L), dtype=bool))[..., None]
    xs = tuple(_to_chunks(t, L) for t in (q, k, v, la))

    def step(s_st, inp):
        qt, kt, vt, at = inp
        cum = jnp.cumsum(at, axis=2)
        rel = jnp.where(mask, cum[:, :, :, None, :] - cum[:, :, None, :, :], -jnp.inf)
        attn = jnp.einsum('bhtd,bhsd,bhtsd->bhts', qt, kt, jnp.exp(rel))
        o = jnp.einsum('bhts,bhse->bhte', attn, vt) + jnp.einsum('bhtd,bhde->bhte', qt * jnp.exp(cum), s_st)
        tot = cum[:, :, -1]
        s_new = jnp.exp(tot)[..., None] * s_st + jnp.einsum('bhsd,bhse->bhde', kt * jnp.exp(tot[:, :, None] - cum), vt)
        return s_new, o

    _, os_ = lax.scan(step, jnp.zeros((bsz, nh, dk, dv), q.dtype), xs)
    return _from_chunks(os_)


def s5_discretise(a_re, a_im, log_dt, b_re, b_im):
    dt = jnp.exp(log_dt)[:, None]
    mag = jnp.exp(dt * a_re)
    lr = mag * jnp.cos(dt * a_im)
    li = mag * jnp.sin(dt * a_im)
    den = a_re * a_re + a_im * a_im
    nr = lr - 1.0
    cr = (nr * a_re + li * a_im) / den
    ci = (li * a_re - nr * a_im) / den
    bbr = cr[..., None] * b_re - ci[..., None] * b_im
    bbi = cr[..., None] * b_im + ci[..., None] * b_re
    return lr, li, bbr, bbi


def s5_scan(ug, lr, li, bbr, bbi, reverse):
    bu_r = jnp.einsum('bsgc,gpc->bsgp', ug, bbr)
    bu_i = jnp.einsum('bsgc,gpc->bsgp', ug, bbi)
    ar = jnp.broadcast_to(lr, bu_r.shape)
    ai = jnp.broadcast_to(li, bu_r.shape)
    _, _, xr, xi = lax.associative_scan(_complex_affine_combine, (ar, ai, bu_r, bu_i), axis=1, reverse=reverse)
    return xr, xi


def s5_mixer(u, a_re, a_im, log_dt, b_re, b_im, c_re, c_im, d, w_glu):
    bsz, s, _ = u.shape
    ug = u.reshape(bsz, s, S5_GROUPS, S5_GROUP)
    fr, fi = s5_scan(ug, *s5_discretise(a_re[0], a_im[0], log_dt[0], b_re, b_im), False)
    br_, bi_ = s5_scan(ug, *s5_discretise(a_re[1], a_im[1], log_dt[1], b_re, b_im), True)
    xr = fr + br_
    xi = fi + bi_
    y = (jnp.einsum('bsgp,gcp->bsgc', xr, c_re) - jnp.einsum('bsgp,gcp->bsgc', xi, c_im)
         + d.reshape(S5_GROUPS, S5_GROUP) * ug)
    y = jax.nn.gelu(y.reshape(bsz, s, S5_W))
    return y * jax.nn.sigmoid(y @ w_glu)


def mixer_cd(h, w_in, gla_w_gate2, gla_gate_b, gla_norm, s5_a_re, s5_a_im, s5_log_dt,
             s5_b_re, s5_b_im, s5_c_re, s5_c_im, s5_d, s5_w_glu, w_out):
    bsz, s, _ = h.shape
    proj = (h @ w_in).astype(jnp.float32)
    q, k, v, r, glr, u = _split(proj, CD_SPLITS)
    q = _heads(q, GLA_HEADS) * (GLA_DK ** -0.5)
    k = _heads(k, GLA_HEADS)
    v = _heads(v, GLA_HEADS)
    low = glr.reshape(bsz, s, 2, GLA_RANK)
    gate_pre = jnp.einsum('bsdr,drk->dbsk', low, gla_w_gate2) + gla_gate_b[:, None, None, :]
    la = (jax.nn.log_sigmoid(gate_pre) / GLA_TAU).reshape(2, bsz, s, GLA_HEADS, GLA_DK).transpose(0, 1, 3, 2, 4)
    o_f = gla_chunked(q, k, v, la[0])
    o_b = _flip_seq(gla_chunked(_flip_seq(q), _flip_seq(k), _flip_seq(v), _flip_seq(la[1])))
    y_c = headwise_rms_norm((o_f + o_b).transpose(0, 2, 1, 3), gla_norm) * jax.nn.silu(r)
    y_d = s5_mixer(u, s5_a_re, s5_a_im, s5_log_dt, s5_b_re, s5_b_im, s5_c_re, s5_c_im, s5_d, s5_w_glu)
    y = jnp.concatenate([y_c, y_d], axis=-1)
    return y.astype(h.dtype) @ w_out


def setup_inputs(seed: int = 0) -> dict:
    key = jax.random.key(seed)
    keys = iter(jax.random.split(key, 48))
    n_even = (DEPTH + 1) // 2
    n_odd = DEPTH // 2
    f32 = jnp.float32

    def normal(shape, scale):
        return scale * jax.random.normal(next(keys), shape, f32)

    def gain(shape):
        return 1.0 + 0.02 * jax.random.normal(next(keys), shape, f32)

    def uniform(shape, lo, hi):
        return jax.random.uniform(next(keys), shape, f32, lo, hi)

    x = normal((BATCH, SEQ, D_MODEL), 1.0)
    norm_ffn1 = gain((DEPTH, D_MODEL))
    ffn1_w_gu = normal((DEPTH, D_MODEL, 2 * D_FF), D_MODEL ** -0.5)
    ffn1_w_down = normal((DEPTH, D_FF, D_MODEL), D_FF ** -0.5)
    norm_mix = gain((DEPTH, D_MODEL))
    norm_ffn2 = gain((DEPTH, D_MODEL))
    ffn2_w_gu = normal((DEPTH, D_MODEL, 2 * D_FF), D_MODEL ** -0.5)
    ffn2_w_down = normal((DEPTH, D_FF, D_MODEL), D_FF ** -0.5)

    ab_w_in = normal((n_even, D_MODEL, AB_IN), D_MODEL ** -0.5)
    lru_conv_w = normal((n_even, CONV_W, W_LRU), CONV_W ** -0.5)
    lru_conv_b = normal((n_even, W_LRU), 0.02)
    lru_gate_w = normal((n_even, 2, 2, LRU_HEADS, LRU_BLOCK, LRU_BLOCK), LRU_BLOCK ** -0.5)
    lru_gate_b = normal((n_even, 2, 2, W_LRU), 0.02)
    a_c = uniform((n_even, 2, W_LRU), 0.9, 0.999)
    a0 = a_c ** (1.0 / LRU_C)
    lru_lambda = jnp.log(a0) - jnp.log1p(-a0)
    i_bias = normal((n_even, 2, MLSTM_HEADS), 0.1)
    f_bias = jnp.linspace(3.0, 6.0, MLSTM_HEADS, dtype=f32) + normal((n_even, 2, MLSTM_HEADS), 0.1)
    mlstm_gate_b = jnp.stack([i_bias, f_bias], axis=2)
    mlstm_norm = gain((n_even, W_MLSTM))
    ab_w_out = normal((n_even, MIX_OUT, D_MODEL), MIX_OUT ** -0.5)

    cd_w_in = normal((n_odd, D_MODEL, CD_IN), D_MODEL ** -0.5)
    gla_w_gate2 = normal((n_odd, 2, GLA_RANK, GLA_QK), GLA_RANK ** -0.5)
    gla_gate_b = normal((n_odd, 2, GLA_QK), 0.1)
    gla_norm = gain((n_odd, GLA_V))
    s5_a_re = -0.5 + normal((n_odd, 2, S5_GROUPS, S5_P), 0.01)
    s5_a_im = math.pi * jnp.arange(S5_P, dtype=f32) + normal((n_odd, 2, S5_GROUPS, S5_P), 0.01)
    s5_log_dt = uniform((n_odd, 2, S5_GROUPS), math.log(S5_DT_MIN), math.log(S5_DT_MAX))
    s5_b_re = normal((n_odd, S5_GROUPS, S5_P, S5_GROUP), (2 * S5_GROUP) ** -0.5)
    s5_b_im = normal((n_odd, S5_GROUPS, S5_P, S5_GROUP), (2 * S5_GROUP) ** -0.5)
    s5_c_re = normal((n_odd, S5_GROUPS, S5_GROUP, S5_P), S5_P ** -0.5)
    s5_c_im = normal((n_odd, S5_GROUPS, S5_GROUP, S5_P), S5_P ** -0.5)
    s5_d = normal((n_odd, S5_W), 1.0)
    s5_w_glu = normal((n_odd, S5_W, S5_W), S5_W ** -0.5)
    cd_w_out = normal((n_odd, MIX_OUT, D_MODEL), MIX_OUT ** -0.5)
    final_norm = gain((D_MODEL,))
    return {
        'x': x,
        'norm_ffn1': norm_ffn1, 'ffn1_w_gu': ffn1_w_gu, 'ffn1_w_down': ffn1_w_down,
        'norm_mix': norm_mix,
        'norm_ffn2': norm_ffn2, 'ffn2_w_gu': ffn2_w_gu, 'ffn2_w_down': ffn2_w_down,
        'ab_w_in': ab_w_in, 'lru_conv_w': lru_conv_w, 'lru_conv_b': lru_conv_b,
        'lru_gate_w': lru_gate_w, 'lru_gate_b': lru_gate_b, 'lru_lambda': lru_lambda,
        'mlstm_gate_b': mlstm_gate_b, 'mlstm_norm': mlstm_norm, 'ab_w_out': ab_w_out,
        'cd_w_in': cd_w_in, 'gla_w_gate2': gla_w_gate2, 'gla_gate_b': gla_gate_b, 'gla_norm': gla_norm,
        's5_a_re': s5_a_re, 's5_a_im': s5_a_im, 's5_log_dt': s5_log_dt,
        's5_b_re': s5_b_re, 's5_b_im': s5_b_im, 's5_c_re': s5_c_re, 's5_c_im': s5_c_im,
        's5_d': s5_d, 's5_w_glu': s5_w_glu, 'cd_w_out': cd_w_out,
        'final_norm': final_norm,
    }


def reference(x, norm_ffn1, ffn1_w_gu, ffn1_w_down, norm_mix, norm_ffn2, ffn2_w_gu, ffn2_w_down,
              ab_w_in, lru_conv_w, lru_conv_b, lru_gate_w, lru_gate_b, lru_lambda, mlstm_gate_b,
              mlstm_norm, ab_w_out, cd_w_in, gla_w_gate2, gla_gate_b, gla_norm, s5_a_re, s5_a_im,
              s5_log_dt, s5_b_re, s5_b_im, s5_c_re, s5_c_im, s5_d, s5_w_glu, cd_w_out, final_norm):
    for l in range(DEPTH):
        x = x + 0.5 * swiglu(rms_norm(x, norm_ffn1[l]), ffn1_w_gu[l], ffn1_w_down[l])
        hn = rms_norm(x, norm_mix[l])
        j = l // 2
        if l % 2 == 0:
            x = x + mixer_ab(hn, ab_w_in[j], lru_conv_w[j], lru_conv_b[j], lru_gate_w[j], lru_gate_b[j],
                             lru_lambda[j], mlstm_gate_b[j], mlstm_norm[j], ab_w_out[j])
        else:
            x = x + mixer_cd(hn, cd_w_in[j], gla_w_gate2[j], gla_gate_b[j], gla_norm[j], s5_a_re[j],
                             s5_a_im[j], s5_log_dt[j], s5_b_re[j], s5_b_im[j], s5_c_re[j], s5_c_im[j],
                             s5_d[j], s5_w_glu[j], cd_w_out[j])
        x = x + 0.5 * swiglu(rms_norm(x, norm_ffn2[l]), ffn2_w_gu[l], ffn2_w_down[l])
    return rms_norm(x, final_norm)
```

```cpp
#define DBG_SKIP 0
#define DBG_DUP 0
#define DBG_XSYNC 0
#include <hip/hip_runtime.h>
#include <hip/hip_cooperative_groups.h>
#include <cstdio>
#include <cstdint>
namespace cg = cooperative_groups;
namespace pg8 {
#define PG8_LAS __attribute__((address_space(3)))
typedef unsigned short bf16_t;
typedef short bf16x8 __attribute__((ext_vector_type(8)));
typedef float f32x4 __attribute__((ext_vector_type(4)));
typedef unsigned u32x4 __attribute__((ext_vector_type(4)));
constexpr int BM = 256, BK = 64, HALF = 128, HTB = HALF * BK * 2  , STAGE_BYTES = 8 * HTB, NXCD = 8, WGM = 8;

__host__ __device__ __forceinline__ int lds_byte(int r, int c) { const int st = (r >> 4) * 2 + (c >> 5), rr = r & 15, cc = c & 31, ob = rr * 64 + cc * 2; return st * 1024 + (ob ^ (((ob >> 9) & 1) << 5)); }
__host__ __device__ __forceinline__ void stage_rc(int b, int& R, int& C) { const int st = b / 1024, sb = b % 1024, swz = sb ^ (((sb >> 9) & 1) << 5); R = (st >> 1) * 16 + swz / 64; C = (st & 1) * 32 + (swz % 64) / 2; }
__host__ __device__ __forceinline__ int perm32(int rho) { const int n = rho >> 4, i = rho & 15; return 8 * (i >> 2) + 4 * n + (i & 3); }

struct Unit { int pm, pn; };
struct Gemm { const bf16_t* A; const bf16_t* Bt; int M, N, K; };

struct StaticOrder {
    int nM, nN, nwg, G, c;
    __host__ __device__ void init(int M, int N, int G_, int c_) { nM = M / BM; nN = N / BM; nwg = nM * nN; G = G_; c = c_; }
    __host__ __device__ bool next(int i, Unit& u) const {
        const long L = (long)i * G + c; if (L >= nwg) return false;
        int wgid = (int)L; { const int q = nwg / NXCD, r = nwg % NXCD, xcd = wgid % NXCD, off = wgid / NXCD; wgid = (xcd < r ? xcd * (q + 1) : r * (q + 1) + (xcd - r) * q) + off; }
        const int nig = WGM * nN, gid = wgid / nig, fm = gid * WGM, gsz = (nM - fm) < WGM ? (nM - fm) : WGM;
        u.pm = fm + ((wgid % nig) % gsz); u.pn = (wgid % nig) / gsz; return true;
    }
    __device__ __forceinline__ void a_ready(const Unit&) const {}
    __device__ __forceinline__ void done(const Unit&) const {}
};

typedef __bf16 bf16x2_t __attribute__((ext_vector_type(2)));
__device__ __forceinline__ unsigned cvt_pk_bf16(float lo, float hi) { bf16x2_t v = {(__bf16)lo, (__bf16)hi}; return __builtin_bit_cast(unsigned, v); }
typedef float f32x2 __attribute__((ext_vector_type(2)));
__device__ __forceinline__ float ep_sigmoid(float x) { return __builtin_amdgcn_rcpf(1.0f + __expf(-x)); }
typedef unsigned long long rowss_t;
__device__ __forceinline__ float ep_rstd(const rowss_t* rowss, int row) { return __builtin_amdgcn_rsqf((float)rowss[row] * (1.0f / 16777216.0f) * (1.0f / 2048.0f) + 1e-6f); }
struct EpiStoreBf16 {
    static constexpr bool PERM = true, AFTER_DRAIN = false;
    bf16_t* O; int ldc; const rowss_t* rowss; bf16_t* O2; int c2_lo;
    __device__ __forceinline__ void operator()(const f32x4 (&acc)[2][2][4][2], const Unit& u, int wr, int wc, int fr, int fq) const {
        const int row0 = u.pm * BM + wr * 64 + fr; const int col0 = u.pn * BM + wc * 32 + 8 * fq;
#pragma unroll
        for (int ai = 0; ai < 2; ++ai)
#pragma unroll
            for (int m = 0; m < 4; ++m) { bf16_t* rowp = O + (size_t)(row0 + ai * HALF + m * 16) * ldc + col0;
                const float rs = rowss ? ep_rstd(rowss, row0 + ai * HALF + m * 16) : 1.0f;
#pragma unroll
                for (int bj = 0; bj < 2; ++bj) { const f32x4 v0 = acc[ai][bj][m][0] * rs, v1 = acc[ai][bj][m][1] * rs;
                    u32x4 w; w.x = cvt_pk_bf16(v0[0], v0[1]); w.y = cvt_pk_bf16(v0[2], v0[3]); w.z = cvt_pk_bf16(v1[0], v1[1]); w.w = cvt_pk_bf16(v1[2], v1[3]);
                    *(u32x4*)(rowp + bj * HALF) = w;
                    if (O2 && col0 + bj * HALF >= c2_lo) { const int cc = col0 + bj * HALF - c2_lo; *(u32x4*)(O2 + ((size_t)(cc >> 4) * 16384 + (row0 + ai * HALF + m * 16)) * 16 + (cc & 15)) = w; } } }
    }
};
struct EpiSwiglu {
    static constexpr bool PERM = true, AFTER_DRAIN = false;
    bf16_t* O; int ldo; const rowss_t* rowss;
    __device__ __forceinline__ void operator()(const f32x4 (&acc)[2][2][4][2], const Unit& u, int wr, int wc, int fr, int fq) const {
        const int row0 = u.pm * BM + wr * 64 + fr; const int col0 = u.pn * HALF + wc * 32 + 8 * fq;
#pragma unroll
        for (int ai = 0; ai < 2; ++ai)
#pragma unroll
            for (int m = 0; m < 4; ++m) { bf16_t* rowp = O + (size_t)(row0 + ai * HALF + m * 16) * ldo + col0;
                float o[8]; const float rs = rowss ? ep_rstd(rowss, row0 + ai * HALF + m * 16) : 1.0f;
#pragma unroll
                for (int n = 0; n < 2; ++n)
#pragma unroll
                    for (int j = 0; j < 4; ++j) { const float g = acc[ai][0][m][n][j] * rs, uu = acc[ai][1][m][n][j] * rs; o[4 * n + j] = g * ep_sigmoid(g) * uu; }
                u32x4 w; w.x = cvt_pk_bf16(o[0], o[1]); w.y = cvt_pk_bf16(o[2], o[3]); w.z = cvt_pk_bf16(o[4], o[5]); w.w = cvt_pk_bf16(o[6], o[7]);
                *(u32x4*)rowp = w; }
    }
};
struct EpiResid {
    static constexpr bool PERM = false, AFTER_DRAIN = false;
    const float* base; float* out; int ldc; float scale; bf16_t* xg; const float* gn; rowss_t* rowss;
    __device__ __forceinline__ void operator()(const f32x4 (&acc)[2][2][4][2], const Unit& u, int wr, int wc, int fr, int fq) const {
        const int row0 = u.pm * BM + wr * 64 + fr; const int col0 = u.pn * BM + wc * 32 + 4 * fq;
        f32x4 gv[2][2];
#pragma unroll
        for (int bj = 0; bj < 2; ++bj)
#pragma unroll
            for (int n = 0; n < 2; ++n) gv[bj][n] = xg ? *(const f32x4*)(gn + col0 + bj * HALF + n * 16) : (f32x4){0.f, 0.f, 0.f, 0.f};
#pragma unroll
        for (int ai = 0; ai < 2; ++ai)
#pragma unroll
            for (int m = 0; m < 4; ++m) { const size_t off = (size_t)(row0 + ai * HALF + m * 16) * ldc + col0; float ss = 0.f;
#pragma unroll
                for (int bj = 0; bj < 2; ++bj)
#pragma unroll
                    for (int n = 0; n < 2; ++n) { const f32x4 bs = *(const f32x4*)(base + off + bj * HALF + n * 16); const f32x4 o = bs + acc[ai][bj][m][n] * scale;
                        *(f32x4*)(out + off + bj * HALF + n * 16) = o;
                        if (xg) { ss += (o[0] * o[0] + o[1] * o[1]) + (o[2] * o[2] + o[3] * o[3]); const f32x4 og = o * gv[bj][n];
                            typedef unsigned u32x2v __attribute__((ext_vector_type(2))); u32x2v w; w.x = cvt_pk_bf16(og[0], og[1]); w.y = cvt_pk_bf16(og[2], og[3]); *(u32x2v*)(xg + off + bj * HALF + n * 16) = w; } }
                if (xg) { ss += __shfl_xor(ss, 16); ss += __shfl_xor(ss, 32); if (fq == 0) atomicAdd(rowss + row0 + ai * HALF + m * 16, (rowss_t)(ss * 16777216.0f)); } }
    }
};
struct EpiGlu {
    static constexpr bool PERM = true, AFTER_DRAIN = false;
    const bf16_t* Y; int ldy; bf16_t* O; int ldo;
    __device__ __forceinline__ void operator()(const f32x4 (&acc)[2][2][4][2], const Unit& u, int wr, int wc, int fr, int fq) const {
        const int row0 = u.pm * BM + wr * 64 + fr; const int col0 = u.pn * BM + wc * 32 + 8 * fq;
#pragma unroll
        for (int ai = 0; ai < 2; ++ai)
#pragma unroll
            for (int m = 0; m < 4; ++m) { const size_t r = (size_t)(row0 + ai * HALF + m * 16);
#pragma unroll
                for (int bj = 0; bj < 2; ++bj) { const int c = col0 + bj * HALF; const u32x4 yv = *(const u32x4*)(Y + r * ldy + c);
                    const f32x4 v0 = acc[ai][bj][m][0], v1 = acc[ai][bj][m][1];
                    float y[8]; y[0] = __uint_as_float(yv.x << 16); y[1] = __uint_as_float(yv.x & 0xffff0000u); y[2] = __uint_as_float(yv.y << 16); y[3] = __uint_as_float(yv.y & 0xffff0000u);
                    y[4] = __uint_as_float(yv.z << 16); y[5] = __uint_as_float(yv.z & 0xffff0000u); y[6] = __uint_as_float(yv.w << 16); y[7] = __uint_as_float(yv.w & 0xffff0000u);
                    u32x4 w; w.x = cvt_pk_bf16(y[0] * ep_sigmoid(v0[0]), y[1] * ep_sigmoid(v0[1])); w.y = cvt_pk_bf16(y[2] * ep_sigmoid(v0[2]), y[3] * ep_sigmoid(v0[3]));
                    w.z = cvt_pk_bf16(y[4] * ep_sigmoid(v1[0]), y[5] * ep_sigmoid(v1[1])); w.w = cvt_pk_bf16(y[6] * ep_sigmoid(v1[2]), y[7] * ep_sigmoid(v1[3]));
                    *(u32x4*)(O + r * ldo + c) = w; } }
    }
};
template <class Epi, class Sched, bool ALIGN_EPI = false, bool SP2 = false>
__device__ __forceinline__ void gemm_phase(PG8_LAS unsigned char* lds, const Gemm g, const Sched& S, const Epi& E) {
    int tid_ = threadIdx.x; asm volatile("" : "+v"(tid_));
    const int tid = tid_, wid = __builtin_amdgcn_readfirstlane(tid >> 6), lane = tid & 63, wr = wid >> 2, wc = wid & 3, fr = lane & 15, fq = lane >> 4;
    const int K = g.K, nt = K / BK;
    unsigned voffA[2], voffB[2];
#pragma unroll
    for (int i = 0; i < 2; ++i) { int R, C; stage_rc(tid * 16 + i * 8192, R, C); const int Rb = Epi::PERM ? ((R & ~31) + perm32(R & 31)) : R;
        voffA[i] = (unsigned)(R * K + C) * 2u; voffB[i] = (unsigned)(Rb * K + C) * 2u; }
    const size_t kstep = (size_t)(BK * 2);
    const size_t hstep = (size_t)HALF * K * 2;
    const size_t tstep = 2 * hstep;
    const unsigned ldsw = (unsigned)wid * 1024u;
    const int aoff = lds_byte(wr * 64 + fr, fq * 8), boff = lds_byte(wc * 32 + fr, fq * 8);
#define PG8_SA(b, h) (((b) * 2 + (h)) * HTB)
#define PG8_SB(b, h) ((4 + (b) * 2 + (h)) * HTB)
#define PG8_STAGE(bufoff, gbase, voff) do { _Pragma("unroll") for (int _i = 0; _i < 2; ++_i) \
        __builtin_amdgcn_global_load_lds((const unsigned*)((const char*)(gbase) + (voff)[_i]), (PG8_LAS unsigned*)(lds + (bufoff) + ldsw + _i * 8192), 16, 0, 0); } while (0)
#define PG8_LDA(dst, b, h) do { _Pragma("unroll") for (int m = 0; m < 4; ++m) _Pragma("unroll") for (int k = 0; k < 2; ++k) dst[m][k] = *(const PG8_LAS bf16x8*)(lds + PG8_SA(b, h) + aoff + m * 2048 + k * 1024); } while (0)
#define PG8_LDB(dst, b, h) do { _Pragma("unroll") for (int n = 0; n < 2; ++n) _Pragma("unroll") for (int k = 0; k < 2; ++k) dst[n][k] = *(const PG8_LAS bf16x8*)(lds + PG8_SB(b, h) + boff + n * 2048 + k * 1024); } while (0)
#define PG8_MMA(ai, bj, At, Bt) do { __builtin_amdgcn_s_setprio(1); _Pragma("unroll") for (int m = 0; m < 4; ++m) _Pragma("unroll") for (int n = 0; n < 2; ++n) _Pragma("unroll") for (int k = 0; k < 2; ++k) \
        acc[ai][bj][m][n] = __builtin_amdgcn_mfma_f32_16x16x32_bf16(Bt[n][k], At[m][k], acc[ai][bj][m][n], 0, 0, 0); __builtin_amdgcn_s_setprio(0); } while (0)
#define PG8_WAIT_V(n) asm volatile("s_waitcnt vmcnt(" #n ")" ::: "memory")
#define PG8_WAIT_L(n) asm volatile("s_waitcnt lgkmcnt(" #n ")" ::: "memory")
#define PG8_BAR __builtin_amdgcn_s_barrier()
#define PG8_SCHED __builtin_amdgcn_sched_barrier(0)
    Unit cur, nxt; int ui = 0;
    if (!S.next(0, cur)) return;
    f32x4 acc[2][2][4][2];
#pragma unroll
    for (int a = 0; a < 2; ++a)
#pragma unroll
        for (int b = 0; b < 2; ++b)
#pragma unroll
            for (int m = 0; m < 4; ++m)
#pragma unroll
                for (int n = 0; n < 2; ++n) acc[a][b][m][n] = (f32x4){0.f, 0.f, 0.f, 0.f};
    bf16x8 At[4][2], B0[2][2], B1[2][2];
    const char* cA = (const char*)g.A + (size_t)cur.pm * tstep; const char* cB = (const char*)g.Bt + (size_t)cur.pn * tstep;
    S.a_ready(cur);
    if constexpr (SP2) {
        PG8_STAGE(PG8_SB(0, 0), cB, voffB); PG8_STAGE(PG8_SB(0, 1), cB + hstep, voffB); PG8_STAGE(PG8_SA(0, 0), cA, voffA); PG8_STAGE(PG8_SA(0, 1), cA + hstep, voffA);
        if (wr == 1) PG8_BAR;
        PG8_WAIT_V(2); PG8_BAR;
        PG8_STAGE(PG8_SB(1, 0), cB + kstep, voffB); PG8_STAGE(PG8_SA(1, 0), cA + kstep, voffA); PG8_STAGE(PG8_SB(1, 1), cB + hstep + kstep, voffB);
        PG8_WAIT_V(6); PG8_BAR;
    } else {
        PG8_STAGE(PG8_SB(0, 0), cB, voffB); PG8_STAGE(PG8_SA(0, 0), cA, voffA); PG8_STAGE(PG8_SB(0, 1), cB + hstep, voffB); PG8_STAGE(PG8_SA(0, 1), cA + hstep, voffA);
        if (wr == 1) PG8_BAR;
        PG8_WAIT_V(4); PG8_BAR;
        PG8_STAGE(PG8_SB(1, 0), cB + kstep, voffB); PG8_STAGE(PG8_SA(1, 0), cA + kstep, voffA); PG8_STAGE(PG8_SB(1, 1), cB + hstep + kstep, voffB);
        PG8_WAIT_V(6); PG8_BAR;
    }
    for (;;) {
        const bool has_next = S.next(ui + 1, nxt);
        const char* nA = has_next ? (const char*)g.A + (size_t)nxt.pm * tstep : cA; const char* nB = has_next ? (const char*)g.Bt + (size_t)nxt.pn * tstep : cB;
        for (int t = 0; t < nt; t += 2) {
            const bool last = (t == nt - 2);
            const char* a1 = cA + (size_t)(t + 1) * kstep;
            const char* a2 = last ? nA : cA + (size_t)(t + 2) * kstep; const char* b2 = last ? nB : cB + (size_t)(t + 2) * kstep;
            const char* a3 = a2 + kstep; const char* b3 = b2 + kstep;
            if (last && has_next) S.a_ready(nxt);
            if constexpr (SP2) {
            PG8_LDB(B0, 0, 0); PG8_LDB(B1, 0, 1); PG8_SCHED; PG8_LDA(At, 0, 0); PG8_STAGE(PG8_SA(1, 1), a1 + hstep, voffA);
            PG8_WAIT_V(8); PG8_WAIT_L(0); PG8_BAR; PG8_MMA(0, 0, At, B0); PG8_MMA(0, 1, At, B1); PG8_BAR; PG8_SCHED;
            PG8_LDA(At, 0, 1); PG8_STAGE(PG8_SB(0, 0), b2, voffB); PG8_STAGE(PG8_SB(0, 1), b2 + hstep, voffB); PG8_STAGE(PG8_SA(0, 0), a2, voffA);
            PG8_WAIT_V(8); PG8_WAIT_L(0); PG8_BAR; PG8_MMA(1, 0, At, B0); PG8_MMA(1, 1, At, B1); PG8_BAR; PG8_SCHED;
            PG8_LDB(B0, 1, 0); PG8_LDB(B1, 1, 1); PG8_SCHED; PG8_LDA(At, 1, 0); PG8_STAGE(PG8_SA(0, 1), a2 + hstep, voffA);
            PG8_WAIT_V(8); PG8_WAIT_L(0); PG8_BAR; PG8_MMA(0, 0, At, B0); PG8_MMA(0, 1, At, B1); PG8_BAR; PG8_SCHED;
            PG8_LDA(At, 1, 1); PG8_STAGE(PG8_SB(1, 0), b3, voffB); PG8_STAGE(PG8_SB(1, 1), b3 + hstep, voffB); PG8_STAGE(PG8_SA(1, 0), a3, voffA);
            PG8_WAIT_V(8); PG8_WAIT_L(0); PG8_BAR; PG8_MMA(1, 0, At, B0); PG8_MMA(1, 1, At, B1); PG8_BAR; PG8_SCHED;
            } else {
            PG8_LDB(B0, 0, 0); PG8_SCHED; PG8_LDA(At, 0, 0); PG8_STAGE(PG8_SA(1, 1), a1 + hstep, voffA);
            PG8_WAIT_L(8); PG8_BAR; PG8_WAIT_L(0); PG8_MMA(0, 0, At, B0); PG8_BAR; PG8_SCHED;
            PG8_LDB(B1, 0, 1); PG8_STAGE(PG8_SB(0, 0), b2, voffB);
            PG8_BAR; PG8_WAIT_L(0); PG8_MMA(0, 1, At, B1); PG8_BAR;
            PG8_LDA(At, 0, 1); PG8_STAGE(PG8_SA(0, 0), a2, voffA);
            PG8_BAR; PG8_WAIT_L(0); PG8_MMA(1, 0, At, B0); PG8_BAR; PG8_SCHED;
            PG8_STAGE(PG8_SB(0, 1), b2 + hstep, voffB);
            PG8_WAIT_V(6); PG8_BAR; PG8_MMA(1, 1, At, B1); PG8_BAR;
            PG8_LDB(B0, 1, 0); PG8_SCHED; PG8_LDA(At, 1, 0); PG8_STAGE(PG8_SA(0, 1), a2 + hstep, voffA);
            PG8_WAIT_L(8); PG8_BAR; PG8_WAIT_L(0); PG8_MMA(0, 0, At, B0); PG8_BAR; PG8_SCHED;
            PG8_LDB(B1, 1, 1); PG8_STAGE(PG8_SB(1, 0), b3, voffB);
            PG8_BAR; PG8_WAIT_L(0); PG8_MMA(0, 1, At, B1); PG8_BAR;
            PG8_LDA(At, 1, 1); PG8_STAGE(PG8_SA(1, 0), a3, voffA);
            PG8_BAR; PG8_WAIT_L(0); PG8_MMA(1, 0, At, B0); PG8_BAR; PG8_SCHED;
            PG8_STAGE(PG8_SB(1, 1), b3 + hstep, voffB);
            PG8_WAIT_V(6); PG8_BAR; PG8_MMA(1, 1, At, B1); PG8_BAR;
            }
        }
        if constexpr (ALIGN_EPI) { if (wr == 0) PG8_BAR; }
        if constexpr (!Epi::AFTER_DRAIN) { E(acc, cur, wr, wc, fr, fq); S.done(cur); }
        if (!has_next) break;
#pragma unroll
        for (int a = 0; a < 2; ++a)
#pragma unroll
            for (int b = 0; b < 2; ++b)
#pragma unroll
                for (int m = 0; m < 4; ++m)
#pragma unroll
                    for (int n = 0; n < 2; ++n) acc[a][b][m][n] = (f32x4){0.f, 0.f, 0.f, 0.f};
        cur = nxt; cA = nA; cB = nB; ++ui;
        if constexpr (ALIGN_EPI) { if (wr == 1) PG8_BAR; }
    }
    PG8_WAIT_V(0);
    if constexpr (!ALIGN_EPI) { if (wr == 0) PG8_BAR; }
    PG8_BAR;
    if constexpr (Epi::AFTER_DRAIN) { E.fused(acc, cur, wr, wc, fr, fq, lds, wid, lane); S.done(cur); }
#undef PG8_SA
#undef PG8_SB
#undef PG8_STAGE
#undef PG8_LDA
#undef PG8_LDB
#undef PG8_MMA
#undef PG8_WAIT_V
#undef PG8_WAIT_L
#undef PG8_BAR
#undef PG8_SCHED
}
}

#define DI __device__ __forceinline__
#define LAS __attribute__((address_space(3)))
typedef unsigned short bf16;
typedef unsigned v4u __attribute__((ext_vector_type(4)));
typedef unsigned v2u __attribute__((ext_vector_type(2)));
typedef float f32x4 __attribute__((ext_vector_type(4)));
typedef float f32x2 __attribute__((ext_vector_type(2)));
typedef short bf16x8 __attribute__((ext_vector_type(8)));

constexpr int NWAVES = 8, NTHR = 512;
constexpr int BATCH = 2, SEQ = 8192, T = BATCH * SEQ, D = 2048, FF = 5632;
constexpr int AB_N = 6144, AB_LD = 6160, CD_N = 4096, CD_LD = 4128;
constexpr float EPS = 1e-6f;
constexpr size_t MiB = 1u << 20;
constexpr size_t WS_GATES = 1 * MiB, WS_AGG = 3 * MiB, WS_CAR = 5 * MiB, WS_WGT = 6 * MiB;
constexpr size_t WS_GU = 8 * MiB  , WS_DN = 96 * MiB  , WS_MIN = 140 * MiB, WS_MOUT = 164 * MiB, WS_GLU = 172 * MiB, WS_LRUW = 174 * MiB;
constexpr size_t WS_HN = 176 * MiB, WS_YMIX = 240 * MiB, WS_BIG = 304 * MiB, WS_GP = 496 * MiB, WS_HF = 624 * MiB, WS_HB = 656 * MiB, WS_END = 688 * MiB;
constexpr int LDS_BYTES = 147456;

DI float bflo(unsigned w) { return __uint_as_float(w << 16); }
DI float bfhi(unsigned w) { return __uint_as_float(w & 0xffff0000u); }
DI float bf2f(bf16 h) { return __uint_as_float(((unsigned)h) << 16); }
DI unsigned pk2(float lo, float hi) { return pg8::cvt_pk_bf16(lo, hi); }
DI bf16 f2bf(float f) { return (bf16)(pk2(f, 0.f) & 0xffffu); }
DI float sigm(float x) { return __builtin_amdgcn_rcpf(1.0f + __expf(-x)); }
DI float softplus_(float x) { return fmaxf(x, 0.f) + log1pf(__expf(-fabsf(x))); }
DI float logsigmoid_(float x) { return fminf(x, 0.f) - __logf(1.0f + __expf(-fabsf(x))); }
DI float gelu_tanh(float x) { const float u = 0.7978845608028654f * (x + 0.044715f * x * x * x); return x * sigm(2.0f * u); }
DI float wave_sum(float v) {
#pragma unroll
    for (int o = 1; o < 64; o <<= 1) v += __shfl_xor(v, o);
    return v;
}
DI f32x4 mfma16(bf16x8 a, bf16x8 b, f32x4 c) { return __builtin_amdgcn_mfma_f32_16x16x32_bf16(a, b, c, 0, 0, 0); }
template <int KT> DI f32x4 mm16(const LAS bf16* A, int lda, const LAS bf16* B, int ldb, f32x4 acc, int lane) {
    const LAS bf16* a = A + (lane & 15) * lda + (lane >> 4) * 8;
    const LAS bf16* b = B + (lane & 15) * ldb + (lane >> 4) * 8;
#pragma unroll
    for (int k = 0; k < KT; ++k) acc = mfma16(*(const LAS bf16x8*)(a + 32 * k), *(const LAS bf16x8*)(b + 32 * k), acc);
    return acc;
}

#ifndef DBG_SKIP
#define DBG_SKIP 0
#endif
#ifndef DBG_DUP
#define DBG_DUP 0
#endif
#ifndef DBG_XSYNC
#define DBG_XSYNC 0
#endif
#define REP(bit) for (int rep_ = 0; rep_ < ((DBG_DUP & (bit)) ? 2 : 1); ++rep_, __syncthreads())
template <int KT> DI f32x4 mm16_ones(const LAS bf16* A, int lda, int lane) {
    const LAS bf16* a = A + (lane & 15) * lda + (lane >> 4) * 8; f32x4 acc = (f32x4){0.f, 0.f, 0.f, 0.f};
    const bf16x8 ones = {0x3F80, 0x3F80, 0x3F80, 0x3F80, 0x3F80, 0x3F80, 0x3F80, 0x3F80};
#pragma unroll
    for (int k = 0; k < KT; ++k) acc = mfma16(*(const LAS bf16x8*)(a + 32 * k), ones, acc);
    return acc;
}
struct Ctx { LAS unsigned char* lds; int tid, lane, wave, gw, ngw; };

#define RLX_AGENT __ATOMIC_RELAXED, __HIP_MEMORY_SCOPE_AGENT
#define XB_TMO      128
#define XB_XCNT(j)  (256  + 64 * (j))
#define XB_XSUB(j)  (1280 + 64 * (j))
#define XB_XGEN(j)  (2304 + 64 * (j))
#define XB_TOP      3328
#define XB_TOPGEN   3392
#define XCD_BAR_WORDS 3456
#define XB_SPIN_CAP (1u << 18)

__device__ __forceinline__ unsigned xb_ld(unsigned* p)              { return __hip_atomic_load(p, __ATOMIC_RELAXED, __HIP_MEMORY_SCOPE_AGENT); }
__device__ __forceinline__ unsigned xb_add(unsigned* p, unsigned v) { return __hip_atomic_fetch_add(p, v, __ATOMIC_RELAXED, __HIP_MEMORY_SCOPE_AGENT); }
__device__ __forceinline__ unsigned xb_xcc_id() { return (unsigned)__builtin_amdgcn_s_getreg((3 << 11) | 20) & 0xFu; }
#define XB_SPIN(cond, bar) do { unsigned _sp = 0; while (cond) { __builtin_amdgcn_s_sleep(1); \
    if ((++_sp & 255u) == 0u) { if (xb_ld(&(bar)[XB_TMO])) break; if (_sp > XB_SPIN_CAP) { atomicAdd(&(bar)[XB_TMO], 1u); break; } } } } while (0)

struct XcdBarrier {
    unsigned* bar; unsigned x;
    volatile LAS unsigned* st;
};

__device__ __forceinline__ XcdBarrier xcd_barrier_post(unsigned* bar, volatile LAS unsigned* st) {
    XcdBarrier b; b.bar = bar; b.x = xb_xcc_id(); b.st = st;
    if (threadIdx.x == 0) (void)xb_add(&bar[XB_XCNT(b.x)], 1u);
    return b;
}
__device__ __forceinline__ void xcd_barrier_complete(unsigned* bar, unsigned x, unsigned& nloc, unsigned& nx) {
    const unsigned G = gridDim.x * gridDim.y * gridDim.z;
    unsigned sum, cnt, mine, sp = 0u;
    for (;;) {
        sum = 0u; cnt = 0u; mine = 0u;
#pragma unroll
        for (unsigned j = 0; j < 16; ++j) { const unsigned c = xb_ld(&bar[XB_XCNT(j)]); sum += c; cnt += (c > 0u) ? 1u : 0u; mine = (j == x) ? c : mine; }
        if (sum == G) break;
        __builtin_amdgcn_s_sleep(1);
        if ((++sp & 255u) == 0u) { if (xb_ld(&bar[XB_TMO])) break; if (sp > XB_SPIN_CAP) { atomicAdd(&bar[XB_TMO], 1u); break; } }
    }
    nloc = mine > 0u ? mine : 1u; nx = cnt > 0u ? cnt : 1u;
}

__device__ __forceinline__ void xcd_barrier(const XcdBarrier& b) {
    asm volatile("s_waitcnt vmcnt(0)" ::: "memory");
    __syncthreads();
    if (threadIdx.x == 0) {
        unsigned* bar = b.bar;
        __builtin_amdgcn_s_waitcnt(0);
        unsigned nloc = b.st[0], nx = b.st[1];
        if (nloc == 0u) { xcd_barrier_complete(bar, b.x, nloc, nx); b.st[0] = nloc; b.st[1] = nx; }
        const unsigned old = xb_add(&bar[XB_XSUB(b.x)], 1u);
        const unsigned gen = old / nloc;
        if (old + 1u == (gen + 1u) * nloc) {
            __builtin_amdgcn_fence(__ATOMIC_RELEASE, "agent");
            asm volatile("s_waitcnt vmcnt(0)" ::: "memory");
            const unsigned og = xb_add(&bar[XB_TOP], 1u);
            const unsigned tg = og / nx;
            if (og + 1u == (tg + 1u) * nx) xb_add(&bar[XB_TOPGEN], 1u);
            else XB_SPIN(xb_ld(&bar[XB_TOPGEN]) == tg, bar);
            __builtin_amdgcn_fence(__ATOMIC_ACQUIRE, "agent");
            xb_add(&bar[XB_XGEN(b.x)], 1u);
            asm volatile("s_waitcnt vmcnt(0)" ::: "memory");
        } else {
            XB_SPIN(xb_ld(&bar[XB_XGEN(b.x)]) == gen, bar);
            __builtin_amdgcn_fence(__ATOMIC_ACQUIRE, "agent");
            asm volatile("s_waitcnt vmcnt(0)" ::: "memory");
        }
    }
    __syncthreads();
}


DI void half_barrier(unsigned* cnt, unsigned n) {
    asm volatile("s_waitcnt vmcnt(0)" ::: "memory"); __syncthreads();
    if (threadIdx.x == 0) {
        __builtin_amdgcn_fence(__ATOMIC_RELEASE, "agent"); asm volatile("s_waitcnt vmcnt(0)" ::: "memory");
        (void)xb_add(cnt, 1u);
        unsigned sp = 0u; while (xb_ld(cnt) < n) { __builtin_amdgcn_s_sleep(1); if (++sp > (1u << 22)) break; }
        __builtin_amdgcn_fence(__ATOMIC_ACQUIRE, "agent"); asm volatile("s_waitcnt vmcnt(0)" ::: "memory");
    }
    __syncthreads();
}
DI void transpose_item(const float* W, int ldw, int k0, int nsrc, bf16* WT, int K, int drow, LAS float* scr, int lane) {
    float tv[32];
#pragma unroll
    for (int i = 0; i < 32; ++i) { const int kk = 2 * i + (lane >> 5); tv[i] = __builtin_nontemporal_load(W + (size_t)(k0 + kk) * ldw + nsrc + (lane & 31)); }
#pragma unroll
    for (int i = 0; i < 32; ++i) { const int kk = 2 * i + (lane >> 5); scr[kk * 33 + (lane & 31)] = tv[i]; }
    asm volatile("s_waitcnt lgkmcnt(0)" ::: "memory");
    const int c = lane & 7;
#pragma unroll
    for (int j = 0; j < 4; ++j) { const int n = (lane >> 3) + 8 * j; const LAS float* s = scr + (8 * c) * 33 + n;
        v4u o; o.x = pk2(s[0 * 33], s[1 * 33]); o.y = pk2(s[2 * 33], s[3 * 33]); o.z = pk2(s[4 * 33], s[5 * 33]); o.w = pk2(s[6 * 33], s[7 * 33]);
        *(v4u*)(WT + (size_t)(drow + n) * K + k0 + 8 * c) = o; }
    asm volatile("s_waitcnt lgkmcnt(0)" ::: "memory");
}
DI void conv_plain(const Ctx& C, const float* W, int ldw, int K, int N, int src_skip_at, int src_skip, bf16* WT) {
    LAS float* scr = (LAS float*)(C.lds + C.wave * 16384);
    const int nb = N / 32, items = (K / 64) * nb;
    for (int it = C.gw; it < items; it += C.ngw) { const int kb = it / nb, n0 = 32 * (it % nb);
        transpose_item(W, ldw, 64 * kb, n0 < src_skip_at ? n0 : n0 + src_skip, WT, K, n0, scr, C.lane); }
}
DI void conv_gu(const Ctx& C, const float* W, bf16* WT) {
    LAS float* scr = (LAS float*)(C.lds + C.wave * 16384);
    constexpr int nb = 2 * FF / 32, items = (D / 64) * nb;
    for (int it = C.gw; it < items; it += C.ngw) { const int kb = it / nb, n0 = 32 * (it % nb);
        const int j = n0 < FF ? n0 : n0 - FF; const int drow = 256 * (j >> 7) + (n0 < FF ? 0 : 128) + (j & 127);
        transpose_item(W, 2 * FF, 64 * kb, n0, WT, D, drow, scr, C.lane); }
}
DI void conv_small(const Ctx& C, const float* W, int ldw, int col0, int nc, bf16* WT) {
    const int gt = C.gw * 64 + C.lane, ngt = C.ngw * 64;
    for (int i = gt; i < nc * D; i += ngt) { const int c = i / D, k = i % D; WT[i] = f2bf(W[(size_t)k * ldw + col0 + c]); }
}

DI void rms_rows_bf16(const Ctx& C, const float* x, const float* g, bf16* out) {
    for (int m = C.gw; m < T; m += C.ngw) {
        const f32x4* xr = (const f32x4*)(x + (size_t)m * D) + C.lane; f32x4 v[8]; float s = 0.f;
#pragma unroll
        for (int j = 0; j < 8; ++j) { v[j] = xr[64 * j]; s += (v[j].x * v[j].x + v[j].y * v[j].y) + (v[j].z * v[j].z + v[j].w * v[j].w); }
        const float rstd = 1.0f / sqrtf(wave_sum(s) * (1.0f / D) + EPS);
        const f32x4* gr = (const f32x4*)g + C.lane; v2u* o = (v2u*)(out + (size_t)m * D) + C.lane;
#pragma unroll
        for (int j = 0; j < 8; ++j) { const f32x4 gv = gr[64 * j]; v2u w; w.x = pk2(v[j].x * rstd * gv.x, v[j].y * rstd * gv.y); w.y = pk2(v[j].z * rstd * gv.z, v[j].w * rstd * gv.w); o[64 * j] = w; }
    }
}
DI void rms_rows_f32(const Ctx& C, float* x, const float* g) {
    for (int m = C.gw; m < T; m += C.ngw) {
        f32x4* xr = (f32x4*)(x + (size_t)m * D) + C.lane; f32x4 v[8]; float s = 0.f;
#pragma unroll
        for (int j = 0; j < 8; ++j) { v[j] = xr[64 * j]; s += (v[j].x * v[j].x + v[j].y * v[j].y) + (v[j].z * v[j].z + v[j].w * v[j].w); }
        const float rstd = 1.0f / sqrtf(wave_sum(s) * (1.0f / D) + EPS);
        const f32x4* gr = (const f32x4*)g + C.lane;
#pragma unroll
        for (int j = 0; j < 8; ++j) { const f32x4 gv = gr[64 * j]; xr[64 * j] = v[j] * rstd * gv; }
    }
}

template <int NT> DI void gate_gemm(const Ctx& C, const bf16* HN, const bf16* WgT, const float* bias, float* G, const pg8::rowss_t* rowss) {
    const int lane = C.lane;
    for (int rt = C.gw; rt < T / 16; rt += C.ngw) {
        f32x4 acc[NT];
#pragma unroll
        for (int n = 0; n < NT; ++n) acc[n] = (f32x4){0.f, 0.f, 0.f, 0.f};
        const bf16* a = HN + (size_t)(rt * 16 + (lane & 15)) * D + (lane >> 4) * 8;
        const bf16* b = WgT + (size_t)(lane & 15) * D + (lane >> 4) * 8;
#pragma unroll 4
        for (int k = 0; k < D / 32; ++k) { const bf16x8 av = *(const bf16x8*)(a + 32 * k);
#pragma unroll
            for (int n = 0; n < NT; ++n) acc[n] = mfma16(av, *(const bf16x8*)(b + (size_t)n * 16 * D + 32 * k), acc[n]); }
#pragma unroll
        for (int n = 0; n < NT; ++n)
#pragma unroll
            for (int j = 0; j < 4; ++j) { const int row = rt * 16 + (lane >> 4) * 4 + j, col = n * 16 + (lane & 15); G[(size_t)row * (16 * NT) + col] = acc[n][j] * pg8::ep_rstd(rowss, row) + (bias ? bias[col] : 0.f); }
    }
}

DI void lru_gate_phase(const Ctx& C, const bf16* PROJ, const float* conv_w, const float* conv_b, const bf16* LW, const float* gate_b, const float* lam, bf16* LA, bf16* BV) {
    LAS bf16* XC = (LAS bf16*)C.lds;
    LAS float* XF = (LAS float*)(C.lds + 17408);
    const int tid = C.tid, lane = C.lane, w = C.wave;
    for (int item = C.gw / NWAVES; item < (T / 64) * 8; item += C.ngw / NWAVES) {
        const int h = item & 7, tok0 = (item >> 3) * 64;
        {
            const int r = tid >> 3, cs = tid & 7, c0 = h * 128 + cs * 16, tok = tok0 + r, ts = tok & (SEQ - 1);
            float a[16];
#pragma unroll
            for (int i = 0; i < 16; ++i) a[i] = conv_b[c0 + i];
#pragma unroll
            for (int k = 0; k < 4; ++k) { const int tk = ts + k - 2;
                if (tk >= 0 && tk < SEQ) { const v4u* p = (const v4u*)(PROJ + (size_t)(tok + k - 2) * AB_N + c0); const v4u x0 = p[0], x1 = p[1]; const float* wk = conv_w + k * 1024 + c0;
                    a[0] += wk[0] * bflo(x0.x); a[1] += wk[1] * bfhi(x0.x); a[2] += wk[2] * bflo(x0.y); a[3] += wk[3] * bfhi(x0.y); a[4] += wk[4] * bflo(x0.z); a[5] += wk[5] * bfhi(x0.z); a[6] += wk[6] * bflo(x0.w); a[7] += wk[7] * bfhi(x0.w);
                    a[8] += wk[8] * bflo(x1.x); a[9] += wk[9] * bfhi(x1.x); a[10] += wk[10] * bflo(x1.y); a[11] += wk[11] * bfhi(x1.y); a[12] += wk[12] * bflo(x1.z); a[13] += wk[13] * bfhi(x1.z); a[14] += wk[14] * bflo(x1.w); a[15] += wk[15] * bfhi(x1.w); } }
            v4u o0, o1; o0.x = pk2(a[0], a[1]); o0.y = pk2(a[2], a[3]); o0.z = pk2(a[4], a[5]); o0.w = pk2(a[6], a[7]); o1.x = pk2(a[8], a[9]); o1.y = pk2(a[10], a[11]); o1.z = pk2(a[12], a[13]); o1.w = pk2(a[14], a[15]);
            *(LAS v4u*)(XC + r * 136 + cs * 16) = o0; *(LAS v4u*)(XC + r * 136 + cs * 16 + 8) = o1;
#pragma unroll
            for (int i = 0; i < 4; ++i) *(LAS f32x4*)(XF + r * 132 + cs * 16 + 4 * i) = (f32x4){a[4 * i], a[4 * i + 1], a[4 * i + 2], a[4 * i + 3]};
        }
        __syncthreads();
        const int j0 = 16 * w, ch = h * 128 + j0 + (lane & 15);
        bf16x8 bfr[4][4];
#pragma unroll
        for (int g = 0; g < 4; ++g)
#pragma unroll
            for (int k = 0; k < 4; ++k) bfr[g][k] = *(const bf16x8*)(LW + ((size_t)(g * 8 + h) * 128 + j0 + (lane & 15)) * 128 + k * 32 + (lane >> 4) * 8);
        float gb[4], sp[2]; bf16* lap = LA + (size_t)tok0 * 1024 + ch; bf16* bvp = BV + (size_t)tok0 * 1024 + ch;
#pragma unroll
        for (int g = 0; g < 4; ++g) gb[g] = gate_b[g * 1024 + ch];
        sp[0] = softplus_(-lam[ch]); sp[1] = softplus_(-lam[1024 + ch]);
#pragma unroll 1
        for (int rt = 0; rt < 4; ++rt) {
            f32x4 acc[4];
#pragma unroll
            for (int g = 0; g < 4; ++g) acc[g] = (f32x4){0.f, 0.f, 0.f, 0.f};
#pragma unroll
            for (int k = 0; k < 4; ++k) { const bf16x8 av = *(const LAS bf16x8*)(XC + (16 * rt + (lane & 15)) * 136 + k * 32 + (lane >> 4) * 8);
#pragma unroll
                for (int g = 0; g < 4; ++g) acc[g] = mfma16(av, bfr[g][k], acc[g]); }
#pragma unroll
            for (int j = 0; j < 4; ++j) { const int t = 16 * rt + (lane >> 4) * 4 + j; const float xv = XF[t * 132 + j0 + (lane & 15)];
#pragma unroll
                for (int dir = 0; dir < 2; ++dir) { const float r = sigm(acc[dir * 2][j] + gb[dir * 2]), ii = sigm(acc[dir * 2 + 1][j] + gb[dir * 2 + 1]);
                    const float la = -8.0f * r * sp[dir]; const float x2 = 2.0f * la;
                    const float om = x2 > -0.3f ? -x2 * (1.0f + x2 * (0.5f + x2 * (0.16666667f + x2 * (0.041666668f + x2 * 0.008333334f)))) : 1.0f - __expf(x2);
                    const float bv = __builtin_amdgcn_sqrtf(om) * ii * xv; const unsigned o = (unsigned)dir * (unsigned)(T * 1024) + (unsigned)t * 1024u;
                    lap[o] = f2bf(la); bvp[o] = f2bf(bv); } }
        }
        __syncthreads();
    }
}
constexpr int LSEG = 128, LNSEG = SEQ / LSEG;
DI void lru_pass1(const Ctx& C, const bf16* LA, const bf16* BV, f32x2* AGG) {
    const int gt = (C.gw / NWAVES) * NTHR + C.tid, ngt = (C.ngw / NWAVES) * NTHR;
    for (int idx = gt; idx < BATCH * 2 * LNSEG * 512; idx += ngt) {
        const int ch = (idx & 511) * 2, sl = (idx >> 9) & (LNSEG - 1), dir = (idx >> 15) & 1, b = idx >> 16;
        float A0 = 1.f, H0 = 0.f, A1 = 1.f, H1 = 0.f;
        const size_t base = ((size_t)dir * T + (size_t)b * SEQ) * 1024 + ch;
#pragma unroll 16
        for (int i = 0; i < LSEG; ++i) { const int li = sl * LSEG + i, t = dir ? SEQ - 1 - li : li; const unsigned o = (unsigned)t * 1024u;
            const unsigned lw = *(const unsigned*)(LA + base + o), bw = *(const unsigned*)(BV + base + o);
            const float a0 = __expf(bflo(lw)), a1 = __expf(bfhi(lw)); A0 *= a0; H0 = a0 * H0 + bflo(bw); A1 *= a1; H1 = a1 * H1 + bfhi(bw); }
        *(f32x4*)(AGG + ((size_t)((b * 2 + dir) * LNSEG + sl)) * 1024 + ch) = (f32x4){A0, H0, A1, H1};
    }
}
DI void lru_pass3(const Ctx& C, const bf16* LA, const bf16* BV, const f32x2* AGG, const bf16* PROJ, float* HT, bf16* YMIX) {
    const int gt = (C.gw / NWAVES) * NTHR + C.tid, ngt = (C.ngw / NWAVES) * NTHR;
    for (int idx = gt; idx < BATCH * LNSEG * 512; idx += ngt) {
        const int ch = (idx & 511) * 2, seg = (idx >> 9) & (LNSEG - 1), b = idx >> 15;
        float h0 = 0.f, h1 = 0.f;
#pragma unroll 8
        for (int s = 0; s < seg; ++s) { const f32x4 e = *(const f32x4*)(AGG + ((size_t)((b * 2 + 0) * LNSEG + s)) * 1024 + ch); h0 = e.x * h0 + e.y; h1 = e.z * h1 + e.w; }
        const size_t tok0 = (size_t)b * SEQ + seg * LSEG; const bf16* la0 = LA + tok0 * 1024 + ch; const bf16* bv0 = BV + tok0 * 1024 + ch; bf16* yp = YMIX + tok0 * D + ch;
#pragma unroll 16
        for (int i = 0; i < LSEG; ++i) { const unsigned lw = *(const unsigned*)(la0 + i * 1024), bw = *(const unsigned*)(bv0 + i * 1024);
            h0 = __expf(bflo(lw)) * h0 + bflo(bw); h1 = __expf(bfhi(lw)) * h1 + bfhi(bw); *(unsigned*)(yp + i * D) = pk2(h0, h1); }
        h0 = 0.f; h1 = 0.f;
#pragma unroll 8
        for (int s = 0; s < LNSEG - 1 - seg; ++s) { const f32x4 e = *(const f32x4*)(AGG + ((size_t)((b * 2 + 1) * LNSEG + s)) * 1024 + ch); h0 = e.x * h0 + e.y; h1 = e.z * h1 + e.w; }
        const bf16* la1 = la0 + (size_t)T * 1024; const bf16* bv1 = bv0 + (size_t)T * 1024; const bf16* gp = PROJ + tok0 * AB_N + 1024 + ch;
#pragma unroll 16
        for (int i = LSEG - 1; i >= 0; --i) { const unsigned lw = *(const unsigned*)(la1 + i * 1024), bw = *(const unsigned*)(bv1 + i * 1024), gw = *(const unsigned*)(gp + (size_t)i * AB_N), fw = *(const unsigned*)(yp + i * D);
            h0 = __expf(bflo(lw)) * h0 + bflo(bw); h1 = __expf(bfhi(lw)) * h1 + bfhi(bw);
            *(unsigned*)(yp + i * D) = pk2(gelu_tanh(bflo(gw)) * (bflo(fw) + h0), gelu_tanh(bfhi(gw)) * (bfhi(fw) + h1)); }
    }
}

template <int ACT  > DI void hnorm_phase(const Ctx& C, const bf16* HF, const bf16* HB, const float* g, const bf16* gate, int ldg, bf16* Y  ) {
    for (int it0 = 2 * C.gw; it0 < T * 4; it0 += 2 * C.ngw) {
        v2u a[2], b[2], gt[2]; f32x4 gv[2]; size_t o[2]; int hh[2], tk[2];
#pragma unroll
        for (int u = 0; u < 2; ++u) { const int it = it0 + u; tk[u] = it >> 2; hh[u] = it & 3; o[u] = (size_t)tk[u] * 1024 + hh[u] * 256 + 4 * C.lane;
            a[u] = *(const v2u*)(HF + o[u]); b[u] = *(const v2u*)(HB + o[u]); gv[u] = *(const f32x4*)(g + hh[u] * 256 + 4 * C.lane); gt[u] = *(const v2u*)(gate + (size_t)tk[u] * ldg + hh[u] * 256 + 4 * C.lane); }
#pragma unroll
        for (int u = 0; u < 2; ++u) {
            float v[4] = {bflo(a[u].x) + bflo(b[u].x), bfhi(a[u].x) + bfhi(b[u].x), bflo(a[u].y) + bflo(b[u].y), bfhi(a[u].y) + bfhi(b[u].y)};
            const float rstd = 1.0f / sqrtf(wave_sum((v[0] * v[0] + v[1] * v[1]) + (v[2] * v[2] + v[3] * v[3])) * (1.0f / 256.0f) + EPS);
            float z[4] = {bflo(gt[u].x), bfhi(gt[u].x), bflo(gt[u].y), bfhi(gt[u].y)}, r[4];
#pragma unroll
            for (int i = 0; i < 4; ++i) { const float s = sigm(z[i]); r[i] = v[i] * rstd * gv[u][i] * (ACT == 0 ? s : z[i] * s); }
            v2u w; w.x = pk2(r[0], r[1]); w.y = pk2(r[2], r[3]); *(v2u*)(Y + (size_t)tk[u] * D + hh[u] * 256 + 4 * C.lane) = w; }
    }
}

#define TOKOF(c, l) ((size_t)b * SEQ + (size_t)(dir ? SEQ - 1 - ((c) * 64 + (l)) : ((c) * 64 + (l))))
DI float wave_incl_add(float v, int lane) {
#pragma unroll
    for (int o = 1; o < 64; o <<= 1) { const float t = __shfl_up(v, o); if (lane >= o) v += t; }
    return v;
}
DI float wave_incl_max(float v, int lane) {
#pragma unroll
    for (int o = 1; o < 64; o <<= 1) { const float t = __shfl_up(v, o); if (lane >= o) v = fmaxf(v, t); }
    return v;
}
#define LBAR() do { asm volatile("s_waitcnt lgkmcnt(0)" ::: "memory"); __builtin_amdgcn_s_barrier(); asm volatile("" ::: "memory"); } while (0)
DI void mlstm_pre(const Ctx& C, const bf16* PROJ, const float* GATES, f32x4* TAB, bf16* PP) {
    constexpr int LQ = 264, LT = 72;
    LAS bf16* Qs = (LAS bf16*)(C.lds); LAS bf16* Ks = (LAS bf16*)(C.lds + 33792); LAS float* sg = (LAS float*)(C.lds + 67584); LAS float* spm = sg + 64; LAS bf16* Ps = (LAS bf16*)(C.lds + 68096);
    const int tid = C.tid, lane = C.lane, w = C.wave; const float scale = 0.0625f;
    v4u qreg[4], kreg[4];
#define PRE_LOAD(it_) do { const int c = (it_) & 127, chain = (it_) >> 7, dir = chain & 1, h = (chain >> 1) & 3, b = chain >> 3; \
        _Pragma("unroll") for (int i = 0; i < 4; ++i) { const int idx = tid + NTHR * i, row = idx >> 5, cc = idx & 31; const bf16* p = PROJ + TOKOF(c, row) * AB_N + h * 256 + 8 * cc; \
            qreg[i] = *(const v4u*)(p + 2048); kreg[i] = *(const v4u*)(p + 3072); } } while (0)
    if ((int)blockIdx.x < 16 * (SEQ / 64)) PRE_LOAD((int)blockIdx.x);
    for (int item = blockIdx.x; item < 16 * (SEQ / 64); item += gridDim.x) {
        const int c = item & 127, chain = item >> 7, dir = chain & 1, h = (chain >> 1) & 3, b = chain >> 3;
        if (w == 0) { const size_t tok = TOKOF(c, lane); const float ig = GATES[tok * 16 + dir * 8 + h], fg = GATES[tok * 16 + dir * 8 + 4 + h];
            const float cum = wave_incl_add(logsigmoid_(fg), lane); const float g = ig - cum; const float pm = wave_incl_max(g, lane);
            TAB[(size_t)item * 64 + lane] = (f32x4){g, cum, pm, 0.f}; sg[lane] = g; spm[lane] = pm; }
#pragma unroll
        for (int i = 0; i < 4; ++i) { const int idx = tid + NTHR * i, row = idx >> 5, cc = idx & 31; *(LAS v4u*)(Qs + row * LQ + 8 * cc) = qreg[i]; *(LAS v4u*)(Ks + row * LQ + 8 * cc) = kreg[i]; }
        if (item + (int)gridDim.x < 16 * (SEQ / 64)) PRE_LOAD(item + (int)gridDim.x);
        __syncthreads();
#pragma unroll
        for (int q = 0; q < 2; ++q) { const int ti = 2 * w + q, tr = ti >> 2, tc = ti & 3;
            if (tc <= tr) { const f32x4 acc = mm16<8>(Qs + 16 * tr * LQ, LQ, Ks + 16 * tc * LQ, LQ, (f32x4){0.f, 0.f, 0.f, 0.f}, lane);
                const int s = 16 * tc + (lane & 15); const float gs = sg[s];
#pragma unroll
                for (int j = 0; j < 4; ++j) { const int t = 16 * tr + (lane >> 4) * 4 + j; Ps[t * LT + s] = f2bf((s <= t) ? acc[j] * scale * __expf(gs - spm[t]) : 0.f); }
            } else {
#pragma unroll
                for (int j = 0; j < 4; ++j) Ps[(16 * tr + (lane >> 4) * 4 + j) * LT + 16 * tc + (lane & 15)] = 0;
            } }
        __syncthreads();
        { const int row = tid >> 3, cc = tid & 7; *(v4u*)(PP + ((size_t)item * 64 + row) * 64 + 8 * cc) = *(const LAS v4u*)(Ps + row * LT + 8 * cc); }
        __syncthreads();
    }
}
#undef PRE_LOAD
template <bool INSYNC> DI void mlstm_phase(const Ctx& C, const bf16* PROJ, const f32x4* TAB, const bf16* PP, bf16* HF, bf16* HB, const XcdBarrier& xbar) {
    constexpr int LQ = 264, LT = 72;
    LAS bf16* Qs = (LAS bf16*)(C.lds); LAS bf16* KT = (LAS bf16*)(C.lds + 33792); LAS bf16* VT = (LAS bf16*)(C.lds + 70656); LAS bf16* Ps = (LAS bf16*)(C.lds + 75264);
    LAS bf16* ST = (LAS bf16*)(C.lds + 84480); LAS bf16* NB = (LAS bf16*)(C.lds + 101376); LAS float* SC = (LAS float*)(C.lds + 101888);
    LAS float* s_wi = SC, *s_ws = SC + 64, *s_enm = SC + 128, *s_cf = SC + 192, *s_misc = SC + 256;
    const int tid = C.tid, lane = C.lane, w = C.wave;
    const float scale = 0.0625f;
    const bf16x8 ones = {0x3F80, 0x3F80, 0x3F80, 0x3F80, 0x3F80, 0x3F80, 0x3F80, 0x3F80};
    for (int item = blockIdx.x; item < 128; item += gridDim.x) {
        const int chain = (item & 7) * 2 + (item >> 6), eb = (item >> 3) & 7, dir = chain & 1, h = (chain >> 1) & 3, b = chain >> 3;
        bf16* HO = dir ? HB : HF;
        f32x4 Sacc[2][2], nacc[2];
#pragma unroll
        for (int i = 0; i < 2; ++i) { nacc[i] = (f32x4){0.f, 0.f, 0.f, 0.f};
#pragma unroll
            for (int j = 0; j < 2; ++j) Sacc[i][j] = (f32x4){0.f, 0.f, 0.f, 0.f}; }
        float m_st = 0.f;
        for (int i = tid; i < 32 * LQ / 2; i += NTHR) ((LAS unsigned*)ST)[i] = 0u;
        if (tid < 128) ((LAS unsigned*)NB)[tid] = 0u;
        v4u qreg[4], ktr[4], preg; v2u vreg; f32x4 tg = (f32x4){0.f, 0.f, 0.f, 0.f};
#define MLSTM_LOAD(c) do { if (w == 0) tg = TAB[((size_t)chain * 128 + (c)) * 64 + lane]; \
            _Pragma("unroll") for (int i = 0; i < 4; ++i) { const int idx = tid + NTHR * i, row = idx >> 5, cc = idx & 31; qreg[i] = *(const v4u*)(PROJ + TOKOF((c), row) * AB_N + 2048 + h * 256 + 8 * cc); } \
            { const bf16* pt = PROJ + TOKOF((c), lane) * AB_N + h * 256; _Pragma("unroll") for (int i = 0; i < 4; ++i) ktr[i] = *(const v4u*)(pt + 3072 + 32 * w + 8 * i); \
              vreg = *(const v2u*)(pt + 4096 + eb * 32 + 4 * w); } \
            preg = *(const v4u*)(PP + (((size_t)chain * 128 + (c)) * 64 + (tid >> 3)) * 64 + 8 * (tid & 7)); } while (0)
        MLSTM_LOAD(0);
        __syncthreads();
        for (int c = 0; c < SEQ / 64; ++c) {
            if (INSYNC && (c == 43 || c == 86)) xcd_barrier(xbar);
            if (w == 0) { const float g = tg.x, cum = tg.y + tg.w, pm = tg.z;
                const float rr = -fmaxf(pm, m_st); const float gmax = __shfl(pm, 63), tot = __shfl(cum, 63); const float mm = fmaxf(m_st, gmax);
                s_wi[lane] = __expf(m_st + rr); s_ws[lane] = __expf(g - mm); s_enm[lane] = __expf(rr - cum); s_cf[lane] = __expf(pm + rr);
                if (lane == 0) { s_misc[0] = __expf(m_st - mm); s_misc[1] = tot + mm; } }
            LBAR();
            const float wc = s_misc[0]; m_st = s_misc[1];
#pragma unroll
            for (int i = 0; i < 4; ++i) { const int idx = tid + NTHR * i, row = idx >> 5, cc = idx & 31; *(LAS v4u*)(Qs + row * LQ + 8 * cc) = qreg[i]; }
            { const float ws = s_ws[lane];
#pragma unroll
                for (int i = 0; i < 4; ++i) { const v4u k = ktr[i]; LAS bf16* kt = KT + (32 * w + 8 * i) * LT + lane;
                    kt[0 * LT] = f2bf(bflo(k.x) * ws); kt[1 * LT] = f2bf(bfhi(k.x) * ws); kt[2 * LT] = f2bf(bflo(k.y) * ws); kt[3 * LT] = f2bf(bfhi(k.y) * ws);
                    kt[4 * LT] = f2bf(bflo(k.z) * ws); kt[5 * LT] = f2bf(bfhi(k.z) * ws); kt[6 * LT] = f2bf(bflo(k.w) * ws); kt[7 * LT] = f2bf(bfhi(k.w) * ws); }
                LAS bf16* vt = VT + (4 * w) * LT + lane; const v2u v = vreg;
                vt[0 * LT] = (bf16)(v.x & 0xffffu); vt[1 * LT] = (bf16)(v.x >> 16); vt[2 * LT] = (bf16)(v.y & 0xffffu); vt[3 * LT] = (bf16)(v.y >> 16); }
            *(LAS v4u*)(Ps + (tid >> 3) * LT + 8 * (tid & 7)) = preg;
            if (c + 1 < SEQ / 64) MLSTM_LOAD(c + 1);
            LBAR();
            const int fr = lane & 15, fq = lane >> 4;
            bf16x8 vf[2][2];
#pragma unroll
            for (int ct = 0; ct < 2; ++ct)
#pragma unroll
                for (int k = 0; k < 2; ++k) vf[ct][k] = *(const LAS bf16x8*)(VT + (16 * ct + fr) * LT + 32 * k + 8 * fq);
            { const int tr = w >> 1, tc = w & 1;
                f32x4 accO = (f32x4){0.f, 0.f, 0.f, 0.f}, accN = accO, accP = accO, rsum = accO;
#pragma unroll
                for (int k = 0; k < 8; ++k) { const bf16x8 a = *(const LAS bf16x8*)(Qs + (16 * tr + fr) * LQ + 32 * k + 8 * fq);
                    accO = mfma16(a, *(const LAS bf16x8*)(ST + (16 * tc + fr) * LQ + 32 * k + 8 * fq), accO);
                    accN = mfma16(a, *(const LAS bf16x8*)(NB + 32 * k + 8 * fq), accN);
                    if ((k & 1) == 1) __builtin_amdgcn_sched_barrier(0); }
#pragma unroll
                for (int k = 0; k < 2; ++k) { const bf16x8 p = *(const LAS bf16x8*)(Ps + (16 * tr + fr) * LT + 32 * k + 8 * fq);
                    accP = tc ? mfma16(p, vf[1][k], accP) : mfma16(p, vf[0][k], accP); rsum = mfma16(p, ones, rsum); }
#pragma unroll
                for (int j = 0; j < 4; ++j) { const int t = 16 * tr + fq * 4 + j; const float wi = s_wi[t] * scale, cf = s_cf[t];
                    const float num = accO[j] * wi + accP[j] * cf, den = rsum[j] * cf + wi * accN[j];
                    HO[TOKOF(c, t) * 1024 + h * 256 + eb * 32 + 16 * tc + fr] = f2bf(num * __builtin_amdgcn_rcpf(fmaxf(fabsf(den), s_enm[t]))); } }
#pragma unroll
            for (int i = 0; i < 2; ++i) { bf16x8 kf[2];
#pragma unroll
                for (int k = 0; k < 2; ++k) kf[k] = *(const LAS bf16x8*)(KT + (16 * (2 * w + i) + fr) * LT + 32 * k + 8 * fq);
                nacc[i] = nacc[i] * wc; Sacc[i][0] = Sacc[i][0] * wc; Sacc[i][1] = Sacc[i][1] * wc;
#pragma unroll
                for (int k = 0; k < 2; ++k) { Sacc[i][0] = mfma16(kf[k], vf[0][k], Sacc[i][0]); Sacc[i][1] = mfma16(kf[k], vf[1][k], Sacc[i][1]); nacc[i] = mfma16(kf[k], ones, nacc[i]); } }
            LBAR();
#pragma unroll
            for (int i = 0; i < 2; ++i) {
#pragma unroll
                for (int ct = 0; ct < 2; ++ct) { v2u o; o.x = pk2(Sacc[i][ct][0], Sacc[i][ct][1]); o.y = pk2(Sacc[i][ct][2], Sacc[i][ct][3]);
                    *(LAS v2u*)(ST + (16 * ct + fr) * LQ + 16 * (2 * w + i) + fq * 4) = o; }
                if (fr == 0) { v2u o; o.x = pk2(nacc[i][0], nacc[i][1]); o.y = pk2(nacc[i][2], nacc[i][3]); *(LAS v2u*)(NB + 16 * (2 * w + i) + fq * 4) = o; } }
        }
        __syncthreads();
#undef MLSTM_LOAD
    }
}

DI void gla_cum_phase(const Ctx& C, const float* GLR  , const float* w2  , const float* gb  , float* CUM, const bf16* PROJ, bf16* PPG, bf16* QH, bf16* KH) {
    LAS float* low = (LAS float*)C.lds;
    LAS bf16* Qt = (LAS bf16*)(C.lds + 4096); LAS bf16* Kt = (LAS bf16*)(C.lds + 21504); LAS bf16* Ps = (LAS bf16*)(C.lds + 38912);
    const int tid = C.tid, lane = C.lane, w = C.wave;
    for (int item = blockIdx.x; item < BATCH * (SEQ / 64) * 2; item += gridDim.x) {
        const int dir = item & 1, c = (item >> 1) & 127, b = item >> 8;
        __syncthreads();
        for (int i = tid; i < 1024; i += NTHR) { const int l = i >> 4, r = i & 15; const int li = c * 64 + l; const size_t tok = (size_t)b * SEQ + (dir ? SEQ - 1 - li : li); low[i] = GLR[tok * 32 + dir * 16 + r]; }
        __syncthreads();
        float wr[16];
#pragma unroll
        for (int r = 0; r < 16; ++r) wr[r] = w2[(dir * 16 + r) * 512 + tid];
        const float bias = gb[dir * 512 + tid]; float cum = 0.f;
#pragma unroll 4
        for (int l = 0; l < 64; ++l) { float pre = bias;
#pragma unroll
            for (int r4 = 0; r4 < 4; ++r4) { const f32x4 lv = *(const LAS f32x4*)(low + l * 16 + 4 * r4); pre += lv.x * wr[4 * r4] + lv.y * wr[4 * r4 + 1] + lv.z * wr[4 * r4 + 2] + lv.w * wr[4 * r4 + 3]; }
            cum += logsigmoid_(pre) * 0.0625f; const int li = c * 64 + l; const size_t tok = (size_t)b * SEQ + (dir ? SEQ - 1 - li : li);
            CUM[((size_t)dir * T + tok) * 512 + tid] = cum; }
        __syncthreads();
        constexpr int LQ = 136, LT = 72; const float scale = 0.08838834764831845f;
#pragma unroll 1
        for (int h = 0; h < 4; ++h) {
            const float* cref = CUM + ((size_t)dir * T + TOKOF(c, 31)) * 512 + h * 128;
            const float* ctot = CUM + ((size_t)dir * T + TOKOF(c, 63)) * 512 + h * 128; const int chain_ = (b * 4 + h) * 2 + dir;
#pragma unroll
            for (int i = 0; i < 2; ++i) { const int idx = tid + NTHR * i, row = idx >> 4, cc = idx & 15, d0 = 8 * cc; const size_t tok = TOKOF(c, row);
                const v4u qv = *(const v4u*)(PROJ + tok * CD_N + h * 128 + d0), kv = *(const v4u*)(PROJ + tok * CD_N + 512 + h * 128 + d0);
                const float* cp = CUM + ((size_t)dir * T + tok) * 512 + h * 128 + d0;
                const f32x4 c0 = *(const f32x4*)cp, c1 = *(const f32x4*)(cp + 4), r0 = *(const f32x4*)(cref + d0), r1 = *(const f32x4*)(cref + d0 + 4);
                float q[8] = {bflo(qv.x), bfhi(qv.x), bflo(qv.y), bfhi(qv.y), bflo(qv.z), bfhi(qv.z), bflo(qv.w), bfhi(qv.w)};
                float k[8] = {bflo(kv.x), bfhi(kv.x), bflo(kv.y), bfhi(kv.y), bflo(kv.z), bfhi(kv.z), bflo(kv.w), bfhi(kv.w)};
                float cu[8] = {c0.x, c0.y, c0.z, c0.w, c1.x, c1.y, c1.z, c1.w}, cr[8] = {r0.x, r0.y, r0.z, r0.w, r1.x, r1.y, r1.z, r1.w};
                float qt[8], kt[8];
#pragma unroll
                for (int e = 0; e < 8; ++e) { qt[e] = q[e] * scale * __expf(cu[e] - cr[e]); kt[e] = k[e] * __expf(cr[e] - cu[e]); }
                {
                    const f32x4 t0 = *(const f32x4*)(ctot + d0), t1 = *(const f32x4*)(ctot + d0 + 4); const float ct[8] = {t0.x, t0.y, t0.z, t0.w, t1.x, t1.y, t1.z, t1.w};
                    float qh[8], kh[8];
#pragma unroll
                    for (int e = 0; e < 8; ++e) { qh[e] = q[e] * scale * __expf(cu[e]); kh[e] = k[e] * __expf(ct[e] - cu[e]); }
                    const size_t go = (((size_t)chain_ * 128 + c) * 64 + row) * 128 + d0;
                    v4u o2; o2.x = pk2(qh[0], qh[1]); o2.y = pk2(qh[2], qh[3]); o2.z = pk2(qh[4], qh[5]); o2.w = pk2(qh[6], qh[7]); *(v4u*)(QH + go) = o2;
                    o2.x = pk2(kh[0], kh[1]); o2.y = pk2(kh[2], kh[3]); o2.z = pk2(kh[4], kh[5]); o2.w = pk2(kh[6], kh[7]); *(v4u*)(KH + go) = o2; }
                v4u o; o.x = pk2(qt[0], qt[1]); o.y = pk2(qt[2], qt[3]); o.z = pk2(qt[4], qt[5]); o.w = pk2(qt[6], qt[7]); *(LAS v4u*)(Qt + row * LQ + d0) = o;
                o.x = pk2(kt[0], kt[1]); o.y = pk2(kt[2], kt[3]); o.z = pk2(kt[4], kt[5]); o.w = pk2(kt[6], kt[7]); *(LAS v4u*)(Kt + row * LQ + d0) = o; }
            __syncthreads();
#pragma unroll
            for (int q = 0; q < 2; ++q) { const int ti = 2 * w + q, tr = ti >> 2, tc = ti & 3;
                if (tc <= tr) { const f32x4 acc = mm16<4>(Qt + 16 * tr * LQ, LQ, Kt + 16 * tc * LQ, LQ, (f32x4){0.f, 0.f, 0.f, 0.f}, lane); const int s = 16 * tc + (lane & 15);
#pragma unroll
                    for (int j = 0; j < 4; ++j) { const int t = 16 * tr + (lane >> 4) * 4 + j; Ps[t * LT + s] = f2bf((s <= t) ? acc[j] : 0.f); }
                } else {
#pragma unroll
                    for (int j = 0; j < 4; ++j) Ps[(16 * tr + (lane >> 4) * 4 + j) * LT + 16 * tc + (lane & 15)] = 0;
                } }
            __syncthreads();
            { const int row = tid >> 3, cc = tid & 7; const int chain = (b * 4 + h) * 2 + dir; *(v4u*)(PPG + (((size_t)chain * 128 + c) * 64 + row) * 64 + 8 * cc) = *(const LAS v4u*)(Ps + row * LT + 8 * cc); }
        }
    }
}
DI void gla_phase(const Ctx& C, const bf16* PROJ, const float* CUM, const bf16* PPG, const bf16* QH, const bf16* KH, bf16* OF, bf16* OB) {
    constexpr int LQ = 136, LT = 72;
    LAS bf16* Qt = (LAS bf16*)(C.lds); LAS bf16* Qh = (LAS bf16*)(C.lds + 17408); LAS bf16* Kt = (LAS bf16*)(C.lds + 34816); LAS bf16* KT = (LAS bf16*)(C.lds + 52224);
    LAS bf16* VT = (LAS bf16*)(C.lds + 70656); LAS bf16* Ps = (LAS bf16*)(C.lds + 75264); LAS bf16* ST = (LAS bf16*)(C.lds + 84480); LAS float* etot = (LAS float*)(C.lds + 93184);
    const int tid = C.tid, lane = C.lane, w = C.wave;
    const float scale = 0.08838834764831845f;
    if (DBG_SKIP & 16) { for (int i = blockIdx.x * NTHR + tid; i < T * 1024; i += gridDim.x * NTHR) { const int tok = i >> 10, ch = i & 1023; OF[i] = f2bf(CUM[(size_t)tok * 512 + (ch & 511)]); OB[i] = f2bf(CUM[((size_t)T + tok) * 512 + (ch & 511)]); } return; }
    for (int item = blockIdx.x; item < 128; item += gridDim.x) {
        const int chain = (item & 7) * 2 + (item >> 6), eb = (item >> 3) & 7, dir = chain & 1, h = (chain >> 1) & 3, b = chain >> 3;
        bf16* OO = dir ? OB : OF;
        f32x4 Sacc[2];
        Sacc[0] = (f32x4){0.f, 0.f, 0.f, 0.f}; Sacc[1] = Sacc[0];
        for (int i = tid; i < 32 * LQ / 2; i += NTHR) ((LAS unsigned*)ST)[i] = 0u;
        v4u pq[2], tk[2], pp; v2u tv; float tet = 0.f;
#define GLA_LOAD(c) do { const size_t cc_ = (size_t)chain * 128 + (c); \
            pp = *(const v4u*)(PPG + (cc_ * 64 + (tid >> 3)) * 64 + 8 * (tid & 7)); \
            _Pragma("unroll") for (int i = 0; i < 2; ++i) { const int idx = tid + NTHR * i; pq[i] = *(const v4u*)(QH + cc_ * 8192 + (size_t)idx * 8); } \
            { const bf16* kp = KH + (cc_ * 64 + lane) * 128 + 16 * w; tk[0] = *(const v4u*)kp; tk[1] = *(const v4u*)(kp + 8); \
              tv = *(const v2u*)(PROJ + TOKOF((c), lane) * CD_N + 1024 + h * 256 + eb * 32 + 4 * w); } \
            if (tid < 128) tet = CUM[((size_t)dir * T + TOKOF((c), 63)) * 512 + h * 128 + tid]; } while (0)
        GLA_LOAD(0);
        __syncthreads();
        for (int c = 0; c < SEQ / 64; ++c) {
#pragma unroll
            for (int i = 0; i < 2; ++i) { const int idx = tid + NTHR * i, row = idx >> 4, cc = idx & 15; *(LAS v4u*)(Qh + row * LQ + 8 * cc) = pq[i]; }
            *(LAS v4u*)(Ps + (tid >> 3) * LT + 8 * (tid & 7)) = pp;
            if (tid < 128) etot[tid] = __expf(tet);
            { const v4u k0 = tk[0], k1 = tk[1]; const v2u v = tv; LAS bf16* kt = KT + (16 * w) * LT + lane;
                kt[0 * LT] = (bf16)(k0.x & 0xffffu); kt[1 * LT] = (bf16)(k0.x >> 16); kt[2 * LT] = (bf16)(k0.y & 0xffffu); kt[3 * LT] = (bf16)(k0.y >> 16);
                kt[4 * LT] = (bf16)(k0.z & 0xffffu); kt[5 * LT] = (bf16)(k0.z >> 16); kt[6 * LT] = (bf16)(k0.w & 0xffffu); kt[7 * LT] = (bf16)(k0.w >> 16);
                kt[8 * LT] = (bf16)(k1.x & 0xffffu); kt[9 * LT] = (bf16)(k1.x >> 16); kt[10 * LT] = (bf16)(k1.y & 0xffffu); kt[11 * LT] = (bf16)(k1.y >> 16);
                kt[12 * LT] = (bf16)(k1.z & 0xffffu); kt[13 * LT] = (bf16)(k1.z >> 16); kt[14 * LT] = (bf16)(k1.w & 0xffffu); kt[15 * LT] = (bf16)(k1.w >> 16);
                LAS bf16* vt = VT + (4 * w) * LT + lane;
                vt[0 * LT] = (bf16)(v.x & 0xffffu); vt[1 * LT] = (bf16)(v.x >> 16); vt[2 * LT] = (bf16)(v.y & 0xffffu); vt[3 * LT] = (bf16)(v.y >> 16); }
            if (c + 1 < SEQ / 64) GLA_LOAD(c + 1);
            LBAR();
            { const int tr = w >> 1, tc = w & 1;
                f32x4 acc = mm16<4>(Qh + 16 * tr * LQ, LQ, ST + 16 * tc * LQ, LQ, (f32x4){0.f, 0.f, 0.f, 0.f}, lane);
                acc = mm16<2>(Ps + 16 * tr * LT, LT, VT + 16 * tc * LT, LT, acc, lane);
#pragma unroll
                for (int j = 0; j < 4; ++j) { const int t = 16 * tr + (lane >> 4) * 4 + j; OO[TOKOF(c, t) * 1024 + h * 256 + eb * 32 + 16 * tc + (lane & 15)] = f2bf(acc[j]); } }
#pragma unroll
            for (int ct = 0; ct < 2; ++ct) {
#pragma unroll
                for (int j = 0; j < 4; ++j) Sacc[ct][j] *= etot[16 * w + (lane >> 4) * 4 + j];
                Sacc[ct] = mm16<2>(KT + 16 * w * LT, LT, VT + 16 * ct * LT, LT, Sacc[ct], lane); }
            LBAR();
#pragma unroll
            for (int ct = 0; ct < 2; ++ct) { if (DBG_SKIP & 32) break; v2u o; o.x = pk2(Sacc[ct][0], Sacc[ct][1]); o.y = pk2(Sacc[ct][2], Sacc[ct][3]); *(LAS v2u*)(ST + (16 * ct + (lane & 15)) * LQ + 16 * w + (lane >> 4) * 4) = o; }
        }
#undef GLA_LOAD
        __syncthreads();
    }
}

constexpr int SSEG = 128, SNSEG = SEQ / SSEG;
struct S5P { const float *a_re, *a_im, *log_dt, *b_re, *b_im, *c_re, *c_im, *d; };
DI void s5_disc(const S5P& P, int dir, int g, int p, float& lr, float& li, f32x2 (&bb)[16]) {
    const float dt = expf(P.log_dt[dir * 64 + g]); const float are = P.a_re[(dir * 64 + g) * 64 + p], aim = P.a_im[(dir * 64 + g) * 64 + p];
    const float mag = expf(dt * are); lr = mag * cosf(dt * aim); li = mag * sinf(dt * aim);
    const float den = are * are + aim * aim, nr = lr - 1.0f; const float cr = (nr * are + li * aim) / den, ci = (li * are - nr * aim) / den;
    const f32x4* br = (const f32x4*)(P.b_re + (size_t)(g * 64 + p) * 16); const f32x4* bi = (const f32x4*)(P.b_im + (size_t)(g * 64 + p) * 16);
#pragma unroll
    for (int q = 0; q < 4; ++q) { const f32x4 r = br[q], i = bi[q];
#pragma unroll
        for (int e = 0; e < 4; ++e) bb[4 * q + e] = (f32x2){cr * r[e] - ci * i[e], cr * i[e] + ci * r[e]}; }
}
DI f32x2 s5_step(const LAS f32x4* up, const f32x2 (&bb)[16], float lr, float li, f32x2 x) {
    const f32x4 u0 = up[0], u1 = up[1], u2 = up[2], u3 = up[3];
    f32x2 a = bb[0] * u0.x; a += bb[1] * u0.y; a += bb[2] * u0.z; a += bb[3] * u0.w; a += bb[4] * u1.x; a += bb[5] * u1.y; a += bb[6] * u1.z; a += bb[7] * u1.w;
    f32x2 c = bb[8] * u2.x; c += bb[9] * u2.y; c += bb[10] * u2.z; c += bb[11] * u2.w; c += bb[12] * u3.x; c += bb[13] * u3.y; c += bb[14] * u3.z; c += bb[15] * u3.w;
    const f32x2 xs = {x.y, x.x};
    return x * lr + (xs * (f32x2){-li, li} + (a + c));
}
DI void s5_stage_u(const bf16* U  , size_t tok0, LAS bf16* UW, int lane) {
#pragma unroll
    for (int i = 0; i < 4; ++i) { const int q = lane + 64 * i, tl = q >> 1, hf = q & 1; *(LAS v4u*)(UW + tl * 16 + hf * 8) = *(const v4u*)(U + (tok0 + tl) * CD_N + hf * 8); }
    asm volatile("s_waitcnt vmcnt(0) lgkmcnt(0)" ::: "memory");
}
DI void s5_load_u(const LAS bf16* UW, int tl, float (&u)[16]) {
    const v4u a = *(const LAS v4u*)(UW + tl * 16), b = *(const LAS v4u*)(UW + tl * 16 + 8);
    u[0] = bflo(a.x); u[1] = bfhi(a.x); u[2] = bflo(a.y); u[3] = bfhi(a.y); u[4] = bflo(a.z); u[5] = bfhi(a.z); u[6] = bflo(a.w); u[7] = bfhi(a.w);
    u[8] = bflo(b.x); u[9] = bfhi(b.x); u[10] = bflo(b.y); u[11] = bfhi(b.y); u[12] = bflo(b.z); u[13] = bfhi(b.z); u[14] = bflo(b.w); u[15] = bfhi(b.w);
}
DI void s5_passA(const Ctx& C, const S5P& P, const bf16* PROJ, f32x2* END) {
    LAS float* UF = (LAS float*)(C.lds + C.wave * 8192);
    for (int item = C.gw; item < BATCH * SNSEG * 64 * 2; item += C.ngw) {
        const int dir = item & 1, g = (item >> 1) & 63, seg = (item >> 7) & (SNSEG - 1), b = item >> 13; const int lane = C.lane; const size_t tok0 = (size_t)b * SEQ + seg * SSEG;
        float lr, li; f32x2 bb[16]; s5_disc(P, dir, g, lane, lr, li, bb);
#pragma unroll
        for (int i = 0; i < 4; ++i) { const int q = lane + 64 * i, tl = q >> 1, hf = q & 1; const v4u v = *(const v4u*)(PROJ + (tok0 + tl) * CD_N + 3072 + g * 16 + hf * 8);
            *(LAS f32x4*)(UF + tl * 16 + hf * 8) = (f32x4){bflo(v.x), bfhi(v.x), bflo(v.y), bfhi(v.y)}; *(LAS f32x4*)(UF + tl * 16 + hf * 8 + 4) = (f32x4){bflo(v.z), bfhi(v.z), bflo(v.w), bfhi(v.w)}; }
        f32x2 x = {0.f, 0.f};
#pragma unroll 2
        for (int i = 0; i < SSEG; ++i) { const int tl = dir ? SSEG - 1 - i : i; x = s5_step((const LAS f32x4*)(UF + tl * 16), bb, lr, li, x); }
        const int sl = dir ? SNSEG - 1 - seg : seg;
        END[((size_t)((b * 2 + dir) * SNSEG + sl)) * 4096 + g * 64 + lane] = x;
        asm volatile("s_waitcnt lgkmcnt(0)" ::: "memory");
    }
}
DI void s5_gen_G(const Ctx& C, const S5P& P, bf16* G) {
    for (int item = blockIdx.x; item < 128; item += gridDim.x) { const int dir = item & 1, g = item >> 1, p = C.lane;
        float lr, li; f32x2 bb[16]; s5_disc(P, dir, g, p, lr, li, bb);
        const int j0 = 16 * C.wave; int e0 = dir ? j0 : 127 - (j0 + 15);
        float pr = 1.f, pi = 0.f; { float br = lr, bi = li; int n = e0;
#pragma unroll
            for (int it = 0; it < 7; ++it) { if (n & 1) { const float t = pr * br - pi * bi; pi = pr * bi + pi * br; pr = t; } const float t2 = br * br - bi * bi; bi = 2.f * br * bi; br = t2; n >>= 1; } }
        bf16* gre = G + ((size_t)item * 128 + p) * 2048; bf16* gim = gre + (size_t)64 * 2048;
#pragma unroll 1
        for (int s = 0; s < 16; ++s) { const int j = dir ? j0 + s : j0 + 15 - s;
            float re[16], im[16];
#pragma unroll
            for (int c = 0; c < 16; ++c) { re[c] = pr * bb[c].x - pi * bb[c].y; im[c] = pr * bb[c].y + pi * bb[c].x; }
            v4u o; o.x = pk2(re[0], re[1]); o.y = pk2(re[2], re[3]); o.z = pk2(re[4], re[5]); o.w = pk2(re[6], re[7]); *(v4u*)(gre + j * 16) = o;
            o.x = pk2(re[8], re[9]); o.y = pk2(re[10], re[11]); o.z = pk2(re[12], re[13]); o.w = pk2(re[14], re[15]); *(v4u*)(gre + j * 16 + 8) = o;
            o.x = pk2(im[0], im[1]); o.y = pk2(im[2], im[3]); o.z = pk2(im[4], im[5]); o.w = pk2(im[6], im[7]); *(v4u*)(gim + j * 16) = o;
            o.x = pk2(im[8], im[9]); o.y = pk2(im[10], im[11]); o.z = pk2(im[12], im[13]); o.w = pk2(im[14], im[15]); *(v4u*)(gim + j * 16 + 8) = o;
            const float t = pr * lr - pi * li; pi = pr * li + pi * lr; pr = t; }
    }
}
DI void s5_end_gemm(const Ctx& C, const bf16* PROJ, const bf16* G, float* ENDF) {
    const int lane = C.lane, fr = lane & 15, fq = lane >> 4, w = C.wave;
    for (int item = blockIdx.x; item < 256; item += gridDim.x) { const int nh = item & 1, gd = item >> 1, dir = gd & 1, g = gd >> 1;
        const int ar = 16 * w + fr, ab = ar >> 6, as = ar & 63;
        const bf16* ap = PROJ + ((size_t)g * T + ab * SEQ + as * SSEG) * 16 + 8 * fq;
        const bf16* bp = G + ((size_t)gd * 128 + nh * 64 + fr) * 2048 + 8 * fq;
        f32x4 acc[4];
#pragma unroll
        for (int ct = 0; ct < 4; ++ct) acc[ct] = (f32x4){0.f, 0.f, 0.f, 0.f};
#pragma unroll 4
        for (int ks = 0; ks < 64; ++ks) { const bf16x8 a = *(const bf16x8*)(ap + 32 * ks);
#pragma unroll
            for (int ct = 0; ct < 4; ++ct) acc[ct] = mfma16(a, *(const bf16x8*)(bp + (size_t)ct * 16 * 2048 + 32 * ks), acc[ct]); }
#pragma unroll
        for (int ct = 0; ct < 4; ++ct)
#pragma unroll
            for (int j = 0; j < 4; ++j) { const int r = 16 * w + fq * 4 + j, b = r >> 6, s = r & 63, sl = dir ? SNSEG - 1 - s : s;
                ENDF[((size_t)((b * 2 + dir) * SNSEG + sl)) * 8192 + g * 128 + nh * 64 + ct * 16 + fr] = acc[ct][j]; }
    }
}
DI void s5_passB(const Ctx& C, const S5P& P, const f32x2* END, f32x2* CARR) {
    const int gt = blockIdx.x * NTHR + C.tid;
    if (gt < BATCH * 2 * 4096) { const int p = gt & 63, g = (gt >> 6) & 63, bd = gt >> 12, dir = bd & 1;
        const float dt = expf(P.log_dt[dir * 64 + g]); const float are = P.a_re[(dir * 64 + g) * 64 + p], aim = P.a_im[(dir * 64 + g) * 64 + p];
        const float mag = expf(dt * are); float lr = mag * cosf(dt * aim), li = mag * sinf(dt * aim);
#pragma unroll
        for (int i = 0; i < 7; ++i) { const float nr = lr * lr - li * li, ni = 2.0f * lr * li; lr = nr; li = ni; }
        float cr = 0.f, ci = 0.f;
        for (int sl = 0; sl < SNSEG; ++sl) { const size_t idx = ((size_t)(bd * SNSEG + sl)) * 4096 + (gt & 4095); CARR[idx] = (f32x2){cr, ci}; const f32x2 e = END[idx];
            const float nr = lr * cr - li * ci + e.x, ni = lr * ci + li * cr + e.y; cr = nr; ci = ni; }
    }
}
DI float s5_reduce16(float (&v)[16], int lane) {
    float a[8];
#pragma unroll
    for (int i = 0; i < 8; ++i) { const bool hi = (lane & 32) != 0; const float keep = hi ? v[i + 8] : v[i], send = hi ? v[i] : v[i + 8]; a[i] = keep + __shfl_xor(send, 32); }
    float b[4];
#pragma unroll
    for (int i = 0; i < 4; ++i) { const bool hi = (lane & 16) != 0; const float keep = hi ? a[i + 4] : a[i], send = hi ? a[i] : a[i + 4]; b[i] = keep + __shfl_xor(send, 16); }
    float c[2];
#pragma unroll
    for (int i = 0; i < 2; ++i) { const bool hi = (lane & 8) != 0; const float keep = hi ? b[i + 2] : b[i], send = hi ? b[i] : b[i + 2]; c[i] = keep + __shfl_xor(send, 8); }
    const bool hi = (lane & 4) != 0; const float keep = hi ? c[1] : c[0], send = hi ? c[0] : c[1]; float d = keep + __shfl_xor(send, 4);
    d += __shfl_xor(d, 1); d += __shfl_xor(d, 2);
    return d;
}
template <int DIRN, int SUB> DI void s5_subtile(const LAS float* UF, LAS bf16* XT, float lr, float li, const f32x2 (&bb)[16], f32x2& x,
                                                const bf16x8 (&bfr)[4], f32x4& acc0, f32x4& acc1, int lane) {
#pragma unroll 1
    for (int i = 0; i < 32; ++i) { const int r = DIRN ? 31 - i : i;
        x = s5_step((const LAS f32x4*)(UF + (32 * SUB + r) * 16), bb, lr, li, x);
        const unsigned pkd = pk2(x.x, x.y); XT[r * 136 + lane] = (bf16)(pkd & 0xffffu); XT[r * 136 + 64 + lane] = (bf16)(pkd >> 16); }
#pragma unroll
    for (int ks = 0; ks < 4; ++ks) { const bf16x8 a0 = *(const LAS bf16x8*)(XT + (lane & 15) * 136 + 32 * ks + 8 * (lane >> 4)), a1 = *(const LAS bf16x8*)(XT + (16 + (lane & 15)) * 136 + 32 * ks + 8 * (lane >> 4));
        acc0 = mfma16(a0, bfr[ks], acc0); acc1 = mfma16(a1, bfr[ks], acc1); }
}
template <int DIRN> DI void s5_dir(const S5P& P, const f32x2* END, const LAS float* UF, LAS bf16* XT, int b, int seg, int g, const bf16x8 (&bfr)[4], f32x4 (&acc)[8], int lane) {
    float lr, li; f32x2 bb[16]; s5_disc(P, DIRN, g, lane, lr, li, bb);
    const int sl = DIRN ? SNSEG - 1 - seg : seg; float xr = 0.f, xi = 0.f;
    { float Lr = lr, Li = li;
#pragma unroll
        for (int i = 0; i < 7; ++i) { const float nr = Lr * Lr - Li * Li, ni = 2.0f * Lr * Li; Lr = nr; Li = ni; }
#pragma unroll 8
        for (int j = 0; j < sl; ++j) { const float* ep = (const float*)END + ((size_t)((b * 2 + DIRN) * SNSEG + j)) * 8192 + g * 128 + lane; const f32x2 e = {ep[0], ep[64]}; const float nr = Lr * xr - Li * xi + e.x, ni = Lr * xi + Li * xr + e.y; xr = nr; xi = ni; } }
    f32x2 x = {xr, xi};
    if (DIRN == 0) { s5_subtile<0, 0>(UF, XT, lr, li, bb, x, bfr, acc[0], acc[1], lane); s5_subtile<0, 1>(UF, XT, lr, li, bb, x, bfr, acc[2], acc[3], lane);
                     s5_subtile<0, 2>(UF, XT, lr, li, bb, x, bfr, acc[4], acc[5], lane); s5_subtile<0, 3>(UF, XT, lr, li, bb, x, bfr, acc[6], acc[7], lane); }
    else {           s5_subtile<1, 3>(UF, XT, lr, li, bb, x, bfr, acc[6], acc[7], lane); s5_subtile<1, 2>(UF, XT, lr, li, bb, x, bfr, acc[4], acc[5], lane);
                     s5_subtile<1, 1>(UF, XT, lr, li, bb, x, bfr, acc[2], acc[3], lane); s5_subtile<1, 0>(UF, XT, lr, li, bb, x, bfr, acc[0], acc[1], lane); }
}
DI void s5_passC(const Ctx& C, const S5P& P, const bf16* PROJ, const f32x2* END, bf16* YG  , int item_lo, int item_hi) {
    LAS float* UF = (LAS float*)(C.lds + C.wave * 16896); LAS bf16* XT = (LAS bf16*)(C.lds + C.wave * 16896 + 8192);
    for (int item = item_lo + C.gw; item < item_hi; item += C.ngw) {
        int lane = C.lane; asm volatile("" : "+v"(lane));
        const int g = item & 63, seg = (item >> 6) & (SNSEG - 1), b = item >> 12; const size_t tok0 = (size_t)b * SEQ + seg * SSEG;
#pragma unroll
        for (int i = 0; i < 4; ++i) { const int q = lane + 64 * i, tl = q >> 1, hf = q & 1; const v4u v = *(const v4u*)(PROJ + ((size_t)g * T + tok0 + tl) * 16 + hf * 8);
            *(LAS f32x4*)(UF + tl * 16 + hf * 8) = (f32x4){bflo(v.x), bfhi(v.x), bflo(v.y), bfhi(v.y)}; *(LAS f32x4*)(UF + tl * 16 + hf * 8 + 4) = (f32x4){bflo(v.z), bfhi(v.z), bflo(v.w), bfhi(v.w)}; }
        bf16x8 bfr[4];
#pragma unroll
        for (int ks = 0; ks < 4; ++ks) { const float* src = (ks < 2 ? P.c_re : P.c_im) + (size_t)(g * 16 + (lane & 15)) * 64 + 32 * (ks & 1) + 8 * (lane >> 4); const f32x4 a = *(const f32x4*)src, bq = *(const f32x4*)(src + 4);
            const float sg = ks < 2 ? 1.0f : -1.0f; v4u w; w.x = pk2(sg * a.x, sg * a.y); w.y = pk2(sg * a.z, sg * a.w); w.z = pk2(sg * bq.x, sg * bq.y); w.w = pk2(sg * bq.z, sg * bq.w); bfr[ks] = __builtin_bit_cast(bf16x8, w); }
        f32x4 acc[8];
#pragma unroll
        for (int r = 0; r < 8; ++r) acc[r] = (f32x4){0.f, 0.f, 0.f, 0.f};
        s5_dir<0>(P, END, UF, XT, b, seg, g, bfr, acc, lane);
        s5_dir<1>(P, END, UF, XT, b, seg, g, bfr, acc, lane);
        const float dv = P.d[g * 16 + (lane & 15)];
#pragma unroll
        for (int r = 0; r < 8; ++r)
#pragma unroll
            for (int j = 0; j < 4; ++j) { const int t = 16 * r + (lane >> 4) * 4 + j; const float y = acc[r][j] + dv * UF[t * 16 + (lane & 15)]; YG[(tok0 + t) * 1024 + g * 16 + (lane & 15)] = f2bf(gelu_tanh(y)); }
        asm volatile("s_waitcnt lgkmcnt(0)" ::: "memory");
    }
}
DI void zero_half(const Ctx& C, bf16* Y  ) { for (int it = C.gw; it < T; it += C.ngw) { v4u z = {0u, 0u, 0u, 0u}; *(v4u*)(Y + (size_t)it * D + 16 * C.lane) = z; *(v4u*)(Y + (size_t)it * D + 16 * C.lane + 8) = z; } }
struct Args { const float* in[32]; float* out; unsigned char* ws; int ph_lo, ph_hi; };
constexpr int N_PHASES = 3 + 5 + 2 + 2 + 5 + 2 + 1;

__global__ void __launch_bounds__(NTHR, 2) hybrid_fwd(Args args) {
    extern __shared__ __attribute__((aligned(16))) unsigned char lds_raw[];
    cg::grid_group grid = cg::this_grid();
    LAS unsigned char* const lds0 = (LAS unsigned char*)lds_raw;
    volatile LAS unsigned* xst = (volatile LAS unsigned*)(lds0 + LDS_BYTES - 16);
    if (threadIdx.x == 0) { xst[0] = 0u; xst[1] = 0u; }
    unsigned* barw = (unsigned*)args.ws;
    if (blockIdx.x == 0) for (int i = threadIdx.x; i < XCD_BAR_WORDS; i += NTHR) barw[i] = 0u;
    __syncthreads();
    XcdBarrier xbar; xbar.bar = barw; xbar.x = 0u; xbar.st = xst;
    const int lo = args.ph_lo, hi = args.ph_hi; int ph = 0;
#define X outl
#define GATES ((float*)(wsl + WS_GATES))
#define AGG ((f32x2*)(wsl + WS_AGG))
#define WGT ((bf16*)(wsl + WS_WGT))
#define W_MIN ((bf16*)(wsl + WS_MIN))
#define W_MOUT ((bf16*)(wsl + WS_MOUT))
#define W_GLU ((bf16*)(wsl + WS_GLU))
#define W_LRU ((bf16*)(wsl + WS_LRUW))
#define HN ((bf16*)(wsl + WS_HN))
#define YMIX ((bf16*)(wsl + WS_YMIX))
#define BIG ((bf16*)(wsl + WS_BIG))
#define HF ((bf16*)(wsl + WS_HF))
#define HB ((bf16*)(wsl + WS_HB))
#define GP (wsl + WS_GP)
#define W_GU ((bf16*)(wsl + WS_GU) + (size_t)f * (2 * FF) * D)
#define W_DN ((bf16*)(wsl + WS_DN) + (size_t)f * D * FF)
#define ROWSS ((pg8::rowss_t*)(wsl + WS_CAR))
#define ROWSS_ (ROWSS + (size_t)(l == 0 ? 0 : 3) * T)
#define LA ((bf16*)GP)
#define BV ((bf16*)(GP + 64 * MiB))
#define CUM ((float*)GP)
#define SEND ((f32x2*)(GP + 64 * MiB))
#define YG ((bf16*)(GP + 80 * MiB))
#define MKP const S5P P{args.in[21], args.in[22], args.in[23], args.in[24], args.in[25], args.in[26], args.in[27], args.in[28]}
#define PH_BEGIN if (ph >= lo && ph < hi) { Ctx C; { int t_ = threadIdx.x; asm volatile("" : "+v"(t_)); C.lds = lds0; C.tid = t_; C.lane = t_ & 63; C.wave = __builtin_amdgcn_readfirstlane(t_ >> 6); C.gw = blockIdx.x * NWAVES + C.wave; C.ngw = gridDim.x * NWAVES; } unsigned char* wsl = args.ws; float* outl = args.out; asm volatile("" : "+s"(wsl), "+s"(outl));
#define PH_END } if (ph >= lo && ph + 1 < hi) { if (ph == 0) { grid.sync(); xbar = xcd_barrier_post(barw, xst); } else xcd_barrier(xbar); } ++ph;
    for (int st = 0; st < 6; ++st) {
        const int l = st / 3, k = st % 3;
        if (k == 1 && (DBG_SKIP & (1 << l))) { ph += 5; continue; }
        if (k != 1) {
            const int f = k >> 1;
            if (st == 0) {
            PH_BEGIN
                REP(1) {
                if (st == 0) { for (int i = blockIdx.x * NTHR + C.tid; i < 6 * T; i += gridDim.x * NTHR) ROWSS[i] = 0ull; }
                if (k == 0) {
                    if (l == 0) { conv_gu(C, args.in[2], (bf16*)(wsl + WS_GU)); conv_gu(C, args.in[6], (bf16*)(wsl + WS_GU) + (size_t)(2 * FF) * D);
                        conv_plain(C, args.in[3], D, FF, D, 1 << 30, 0, (bf16*)(wsl + WS_DN)); conv_plain(C, args.in[7], D, FF, D, 1 << 30, 0, (bf16*)(wsl + WS_DN) + (size_t)D * FF);
                        conv_plain(C, args.in[8], AB_LD, D, AB_N, 1 << 30, 0, W_MIN); conv_plain(C, args.in[16], D, D, D, 1 << 30, 0, W_MOUT); conv_small(C, args.in[8], AB_LD, AB_N, 16, WGT);
                        for (int m = 0; m < 32; ++m) conv_plain(C, args.in[11] + (size_t)m * 128 * 128, 128, 128, 128, 1 << 30, 0, W_LRU + (size_t)m * 128 * 128); }
                }
                if (st == 0) rms_rows_bf16(C, args.in[0], args.in[1], HN); }
            PH_END
            }
            PH_BEGIN REP(2) { pg8::Gemm g{HN, W_GU, T, 2 * FF, D}; pg8::StaticOrder S; S.init(T, 2 * FF, gridDim.x, blockIdx.x); pg8::EpiSwiglu E{BIG, FF, st == 0 ? nullptr : ROWSS + (size_t)(st == 2 ? 1 : st == 3 ? 2 : 4) * T};
                pg8::gemm_phase<pg8::EpiSwiglu, pg8::StaticOrder, true, true>(C.lds, g, S, E); }
            PH_END
            PH_BEGIN { pg8::Gemm g{BIG, W_DN, T, D, FF}; pg8::StaticOrder S; S.init(T, D, gridDim.x, blockIdx.x); pg8::EpiResid E{st == 0 ? args.in[0] : X, X, D, 0.5f, st == 5 ? nullptr : HN, st == 0 ? args.in[4] : st == 2 ? args.in[1] + D : args.in[4] + D, ROWSS + (size_t)(st == 0 ? 0 : st == 2 ? 2 : 3) * T};
                pg8::gemm_phase<pg8::EpiResid, pg8::StaticOrder, false, true>(C.lds, g, S, E); }
            PH_END
        } else if (l == 0) {
            PH_BEGIN REP(256) { gate_gemm<1>(C, HN, WGT, args.in[14], GATES, ROWSS_); asm volatile("s_waitcnt vmcnt(0)" ::: "memory"); __syncthreads();
                pg8::Gemm g{HN, W_MIN, T, AB_N, D}; pg8::StaticOrder S; S.init(T, AB_N, gridDim.x, blockIdx.x); pg8::EpiStoreBf16 E{BIG, AB_N, ROWSS_, nullptr, 0};
                pg8::gemm_phase<pg8::EpiStoreBf16, pg8::StaticOrder, true, true>(C.lds, g, S, E); }
            PH_END
            PH_BEGIN REP(1024) mlstm_pre(C, BIG, GATES, (f32x4*)HN, HN + 2 * MiB); PH_END
            PH_BEGIN
                REP(8192) {
                if (blockIdx.x < 128) mlstm_phase<false>(C, BIG, (const f32x4*)HN, HN + 2 * MiB, HF, HB, xbar);
                else { Ctx C2 = C; C2.gw = (blockIdx.x - 128) * NWAVES + C.wave; C2.ngw = (gridDim.x - 128) * NWAVES;
                    REP(16384) lru_gate_phase(C2, BIG, args.in[9], args.in[10], W_LRU, args.in[12], args.in[13], LA, BV); half_barrier(barw + 16, gridDim.x - 128);
                    REP(32768) lru_pass1(C2, LA, BV, AGG); half_barrier(barw + 80, gridDim.x - 128);
                    REP(65536) lru_pass3(C2, LA, BV, AGG, BIG, nullptr, YMIX);
                    __syncthreads();
                    conv_gu(C2, args.in[2] + (size_t)D * 2 * FF, (bf16*)(wsl + WS_GU)); conv_plain(C2, args.in[3] + (size_t)FF * D, D, FF, D, 1 << 30, 0, (bf16*)(wsl + WS_DN));
                    conv_plain(C2, args.in[17], CD_LD, D, CD_N, 3072, 32, W_MIN); conv_small(C2, args.in[17], CD_LD, 3072, 32, WGT); conv_plain(C2, args.in[29], 1024, 1024, 1024, 1 << 30, 0, W_GLU); } }
            PH_END
            PH_BEGIN REP(128) hnorm_phase<0>(C, HF, HB, args.in[15], BIG + 5120, AB_N, YMIX + 1024); PH_END
            PH_BEGIN { pg8::Gemm g{YMIX, W_MOUT, T, D, D}; pg8::StaticOrder S; S.init(T, D, gridDim.x, blockIdx.x); pg8::EpiResid E{X, X, D, 1.0f, HN, args.in[5], ROWSS_ + (size_t)1 * T};
                pg8::gemm_phase<pg8::EpiResid, pg8::StaticOrder, false, true>(C.lds, g, S, E); }
            PH_END
        } else {
            PH_BEGIN REP(256) { { MKP; s5_gen_G(C, P, HF); }
                gate_gemm<2>(C, HN, WGT, nullptr, GATES, ROWSS_); asm volatile("s_waitcnt vmcnt(0)" ::: "memory"); __syncthreads();
                pg8::Gemm g{HN, W_MIN, T, CD_N, D}; pg8::StaticOrder S; S.init(T, CD_N, gridDim.x, blockIdx.x); pg8::EpiStoreBf16 E{BIG, CD_N, ROWSS_, YMIX, 3072};
                pg8::gemm_phase<pg8::EpiStoreBf16, pg8::StaticOrder, true, true>(C.lds, g, S, E); }
            PH_END
            PH_BEGIN MKP; REP(64) { gla_cum_phase(C, GATES, args.in[18], args.in[19], CUM, BIG, HN, BIG + 64 * MiB, BIG + 80 * MiB); __syncthreads(); } REP(32) s5_end_gemm(C, YMIX, HF, (float*)SEND);
                __syncthreads();
                conv_gu(C, args.in[6] + (size_t)D * 2 * FF, (bf16*)(wsl + WS_GU) + (size_t)(2 * FF) * D); conv_plain(C, args.in[7] + (size_t)FF * D, D, FF, D, 1 << 30, 0, (bf16*)(wsl + WS_DN) + (size_t)D * FF);
                conv_plain(C, args.in[30], D, D, D, 1 << 30, 0, W_MOUT); PH_END
            PH_BEGIN
                MKP;
                REP(4096) {
                constexpr int S5_SPLIT = 6144;
                if (blockIdx.x < 128) { gla_phase(C, BIG, CUM, HN, BIG + 64 * MiB, BIG + 80 * MiB, HF, HB); __syncthreads();
                    Ctx C2 = C; C2.ngw = 128 * NWAVES; s5_passC(C2, P, YMIX, SEND, YG, S5_SPLIT, BATCH * SNSEG * 64); }
                else { Ctx C2 = C; C2.gw = (blockIdx.x - 128) * NWAVES + C.wave; C2.ngw = (gridDim.x - 128) * NWAVES; s5_passC(C2, P, YMIX, SEND, YG, 0, S5_SPLIT); } }
            PH_END
            PH_BEGIN REP(2048) { hnorm_phase<1>(C, HF, HB, args.in[20], BIG + 2048, CD_N, YMIX); asm volatile("s_waitcnt vmcnt(0)" ::: "memory"); __syncthreads();
                pg8::Gemm g{YG, W_GLU, T, 1024, 1024}; pg8::StaticOrder S; S.init(T, 1024, gridDim.x, blockIdx.x); pg8::EpiGlu E{YG, 1024, YMIX + 1024, D};
                pg8::gemm_phase<pg8::EpiGlu, pg8::StaticOrder, true, true>(C.lds, g, S, E); }
            PH_END
            PH_BEGIN { pg8::Gemm g{YMIX, W_MOUT, T, D, D}; pg8::StaticOrder S; S.init(T, D, gridDim.x, blockIdx.x); pg8::EpiResid E{X, X, D, 1.0f, HN, args.in[5] + D, ROWSS_ + (size_t)1 * T};
                pg8::gemm_phase<pg8::EpiResid, pg8::StaticOrder, false, true>(C.lds, g, S, E); }
            PH_END
        }
    }
    for (int xs_ = 0; xs_ < DBG_XSYNC; ++xs_) xcd_barrier(xbar);
    PH_BEGIN REP(512) rms_rows_f32(C, X, args.in[31]); PH_END
#undef PH_BEGIN
#undef PH_END
}
#undef X
#undef GATES
#undef AGG
#undef WGT
#undef W_MIN
#undef W_MOUT
#undef W_GLU
#undef W_LRU
#undef HN
#undef YMIX
#undef BIG
#undef HF
#undef HB
#undef GP
#undef W_GU
#undef W_DN
#undef ROWSS
#undef ROWSS_
#undef LA
#undef BV
#undef CUM
#undef SEND
#undef YG
#undef MKP

#ifndef MULTI_LAUNCH
#define MULTI_LAUNCH 0
#endif
extern "C" void kernel_launch(void* const* d_in, const int* in_sizes, int n_in, void* d_out, int out_size, void* d_ws, size_t ws_size, hipStream_t stream) {
    static int grid = 0;
    if (grid == 0) {
        if (n_in != 32 || out_size != T * D || ws_size < WS_END) { fprintf(stderr, "kernel_launch: unexpected shapes (n_in %d out %d ws %zu)\n", n_in, out_size, ws_size); grid = -1; return; }
        int dev = 0, cus = 0, per_cu = 0;
        (void)hipGetDevice(&dev); (void)hipDeviceGetAttribute(&cus, hipDeviceAttributeMultiprocessorCount, dev);
        if (hipFuncSetAttribute((const void*)hybrid_fwd, hipFuncAttributeMaxDynamicSharedMemorySize, LDS_BYTES) != hipSuccess) { fprintf(stderr, "kernel_launch: hipFuncSetAttribute failed\n"); grid = -1; return; }
        if (hipOccupancyMaxActiveBlocksPerMultiprocessor(&per_cu, (const void*)hybrid_fwd, NTHR, LDS_BYTES) != hipSuccess || per_cu < 1) { fprintf(stderr, "kernel_launch: occupancy query gave %d\n", per_cu); per_cu = 1; }
        (void)hipGetLastError();
        grid = cus * 1;
    }
    if (grid < 0) return;
    Args a{};
    for (int i = 0; i < 32; ++i) a.in[i] = (const float*)d_in[i];
    a.out = (float*)d_out; a.ws = (unsigned char*)d_ws;
#if MULTI_LAUNCH
    for (int p = 0; p < N_PHASES; ++p) { a.ph_lo = p; a.ph_hi = p + 1; hipLaunchKernelGGL(hybrid_fwd, dim3(grid), dim3(NTHR), LDS_BYTES, stream, a); }
#else
    a.ph_lo = 0; a.ph_hi = N_PHASES;
    void* kargs[] = {&a};
    const hipError_t e = hipLaunchCooperativeKernel((const void*)hybrid_fwd, dim3(grid), dim3(NTHR), kargs, LDS_BYTES, stream);
    if (e != hipSuccess) fprintf(stderr, "kernel_launch: cooperative launch failed: %s (grid %d)\n", hipGetErrorString(e), grid);
#endif
}
```

```cpp
#define DBG_SKIP 0
#define DBG_DUP 0
#define DBG_XSYNC 0
#include <hip/hip_runtime.h>
#include <hip/hip_cooperative_groups.h>
#include <cstdio>
#include <cstdint>
namespace cg = cooperative_groups;
namespace pg8 {
#define PG8_LAS __attribute__((address_space(3)))
typedef unsigned short bf16_t;
typedef short bf16x8 __attribute__((ext_vector_type(8)));
typedef float f32x4 __attribute__((ext_vector_type(4)));
typedef unsigned u32x4 __attribute__((ext_vector_type(4)));
constexpr int BM = 256, BK = 64, HALF = 128, HTB = HALF * BK * 2  , STAGE_BYTES = 8 * HTB, NXCD = 8, WGM = 8;

__host__ __device__ __forceinline__ int lds_byte(int r, int c) { const int st = (r >> 4) * 2 + (c >> 5), rr = r & 15, cc = c & 31, ob = rr * 64 + cc * 2; return st * 1024 + (ob ^ (((ob >> 9) & 1) << 5)); }
__host__ __device__ __forceinline__ void stage_rc(int b, int& R, int& C) { const int st = b / 1024, sb = b % 1024, swz = sb ^ (((sb >> 9) & 1) << 5); R = (st >> 1) * 16 + swz / 64; C = (st & 1) * 32 + (swz % 64) / 2; }
__host__ __device__ __forceinline__ int perm32(int rho) { const int n = rho >> 4, i = rho & 15; return 8 * (i >> 2) + 4 * n + (i & 3); }

struct Unit { int pm, pn; };
struct Gemm { const bf16_t* A; const bf16_t* Bt; int M, N, K; };

struct StaticOrder {
    int nM, nN, nwg, G, c;
    __host__ __device__ void init(int M, int N, int G_, int c_) { nM = M / BM; nN = N / BM; nwg = nM * nN; G = G_; c = c_; }
    __host__ __device__ bool next(int i, Unit& u) const {
        const long L = (long)i * G + c; if (L >= nwg) return false;
        int wgid = (int)L; { const int q = nwg / NXCD, r = nwg % NXCD, xcd = wgid % NXCD, off = wgid / NXCD; wgid = (xcd < r ? xcd * (q + 1) : r * (q + 1) + (xcd - r) * q) + off; }
        const int nig = WGM * nN, gid = wgid / nig, fm = gid * WGM, gsz = (nM - fm) < WGM ? (nM - fm) : WGM;
        u.pm = fm + ((wgid % nig) % gsz); u.pn = (wgid % nig) / gsz; return true;
    }
    __device__ __forceinline__ void a_ready(const Unit&) const {}
    __device__ __forceinline__ void done(const Unit&) const {}
};

typedef __bf16 bf16x2_t __attribute__((ext_vector_type(2)));
__device__ __forceinline__ unsigned cvt_pk_bf16(float lo, float hi) { bf16x2_t v = {(__bf16)lo, (__bf16)hi}; return __builtin_bit_cast(unsigned, v); }
typedef float f32x2 __attribute__((ext_vector_type(2)));
__device__ __forceinline__ float ep_sigmoid(float x) { return __builtin_amdgcn_rcpf(1.0f + __expf(-x)); }
typedef unsigned long long rowss_t;
__device__ __forceinline__ float ep_rstd(const rowss_t* rowss, int row) { return __builtin_amdgcn_rsqf((float)rowss[row] * (1.0f / 16777216.0f) * (1.0f / 2048.0f) + 1e-6f); }
struct EpiStoreBf16 {
    static constexpr bool PERM = true, AFTER_DRAIN = false;
    bf16_t* O; int ldc; const rowss_t* rowss; bf16_t* O2; int c2_lo;
    __device__ __forceinline__ void operator()(const f32x4 (&acc)[2][2][4][2], const Unit& u, int wr, int wc, int fr, int fq) const {
        const int row0 = u.pm * BM + wr * 64 + fr; const int col0 = u.pn * BM + wc * 32 + 8 * fq;
#pragma unroll
        for (int ai = 0; ai < 2; ++ai)
#pragma unroll
            for (int m = 0; m < 4; ++m) { bf16_t* rowp = O + (size_t)(row0 + ai * HALF + m * 16) * ldc + col0;
                const float rs = rowss ? ep_rstd(rowss, row0 + ai * HALF + m * 16) : 1.0f;
#pragma unroll
                for (int bj = 0; bj < 2; ++bj) { const f32x4 v0 = acc[ai][bj][m][0] * rs, v1 = acc[ai][bj][m][1] * rs;
                    u32x4 w; w.x = cvt_pk_bf16(v0[0], v0[1]); w.y = cvt_pk_bf16(v0[2], v0[3]); w.z = cvt_pk_bf16(v1[0], v1[1]); w.w = cvt_pk_bf16(v1[2], v1[3]);
                    *(u32x4*)(rowp + bj * HALF) = w;
                    if (O2 && col0 + bj * HALF >= c2_lo) { const int cc = col0 + bj * HALF - c2_lo; *(u32x4*)(O2 + ((size_t)(cc >> 4) * 16384 + (row0 + ai * HALF + m * 16)) * 16 + (cc & 15)) = w; } } }
    }
};
struct EpiSwiglu {
    static constexpr bool PERM = true, AFTER_DRAIN = false;
    bf16_t* O; int ldo; const rowss_t* rowss;
    __device__ __forceinline__ void operator()(const f32x4 (&acc)[2][2][4][2], const Unit& u, int wr, int wc, int fr, int fq) const {
        const int row0 = u.pm * BM + wr * 64 + fr; const int col0 = u.pn * HALF + wc * 32 + 8 * fq;
#pragma unroll
        for (int ai = 0; ai < 2; ++ai)
#pragma unroll
            for (int m = 0; m < 4; ++m) { bf16_t* rowp = O + (size_t)(row0 + ai * HALF + m * 16) * ldo + col0;
                float o[8]; const float rs = rowss ? ep_rstd(rowss, row0 + ai * HALF + m * 16) : 1.0f;
#pragma unroll
                for (int n = 0; n < 2; ++n)
#pragma unroll
                    for (int j = 0; j < 4; ++j) { const float g = acc[ai][0][m][n][j] * rs, uu = acc[ai][1][m][n][j] * rs; o[4 * n + j] = g * ep_sigmoid(g) * uu; }
                u32x4 w; w.x = cvt_pk_bf16(o[0], o[1]); w.y = cvt_pk_bf16(o[2], o[3]); w.z = cvt_pk_bf16(o[4], o[5]); w.w = cvt_pk_bf16(o[6], o[7]);
                *(u32x4*)rowp = w; }
    }
};
struct EpiResid {
    static constexpr bool PERM = false, AFTER_DRAIN = false;
    const float* base; float* out; int ldc; float scale; bf16_t* xg; const float* gn; rowss_t* rowss;
    __device__ __forceinline__ void operator()(const f32x4 (&acc)[2][2][4][2], const Unit& u, int wr, int wc, int fr, int fq) const {
        const int row0 = u.pm * BM + wr * 64 + fr; const int col0 = u.pn * BM + wc * 32 + 4 * fq;
        f32x4 gv[2][2];
#pragma unroll
        for (int bj = 0; bj < 2; ++bj)
#pragma unroll
            for (int n = 0; n < 2; ++n) gv[bj][n] = xg ? *(const f32x4*)(gn + col0 + bj * HALF + n * 16) : (f32x4){0.f, 0.f, 0.f, 0.f};
#pragma unroll
        for (int ai = 0; ai < 2; ++ai)
#pragma unroll
            for (int m = 0; m < 4; ++m) { const size_t off = (size_t)(row0 + ai * HALF + m * 16) * ldc + col0; float ss = 0.f;
#pragma unroll
                for (int bj = 0; bj < 2; ++bj)
#pragma unroll
                    for (int n = 0; n < 2; ++n) { const f32x4 bs = *(const f32x4*)(base + off + bj * HALF + n * 16); const f32x4 o = bs + acc[ai][bj][m][n] * scale;
                        *(f32x4*)(out + off + bj * HALF + n * 16) = o;
                        if (xg) { ss += (o[0] * o[0] + o[1] * o[1]) + (o[2] * o[2] + o[3] * o[3]); const f32x4 og = o * gv[bj][n];
                            typedef unsigned u32x2v __attribute__((ext_vector_type(2))); u32x2v w; w.x = cvt_pk_bf16(og[0], og[1]); w.y = cvt_pk_bf16(og[2], og[3]); *(u32x2v*)(xg + off + bj * HALF + n * 16) = w; } }
                if (xg) { ss += __shfl_xor(ss, 16); ss += __shfl_xor(ss, 32); if (fq == 0) atomicAdd(rowss + row0 + ai * HALF + m * 16, (rowss_t)(ss * 16777216.0f)); } }
    }
};
struct EpiGlu {
    static constexpr bool PERM = true, AFTER_DRAIN = false;
    const bf16_t* Y; int ldy; bf16_t* O; int ldo;
    __device__ __forceinline__ void operator()(const f32x4 (&acc)[2][2][4][2], const Unit& u, int wr, int wc, int fr, int fq) const {
        const int row0 = u.pm * BM + wr * 64 + fr; const int col0 = u.pn * BM + wc * 32 + 8 * fq;
#pragma unroll
        for (int ai = 0; ai < 2; ++ai)
#pragma unroll
            for (int m = 0; m < 4; ++m) { const size_t r = (size_t)(row0 + ai * HALF + m * 16);
#pragma unroll
                for (int bj = 0; bj < 2; ++bj) { const int c = col0 + bj * HALF; const u32x4 yv = *(const u32x4*)(Y + r * ldy + c);
                    const f32x4 v0 = acc[ai][bj][m][0], v1 = acc[ai][bj][m][1];
                    float y[8]; y[0] = __uint_as_float(yv.x << 16); y[1] = __uint_as_float(yv.x & 0xffff0000u); y[2] = __uint_as_float(yv.y << 16); y[3] = __uint_as_float(yv.y & 0xffff0000u);
                    y[4] = __uint_as_float(yv.z << 16); y[5] = __uint_as_float(yv.z & 0xffff0000u); y[6] = __uint_as_float(yv.w << 16); y[7] = __uint_as_float(yv.w & 0xffff0000u);
                    u32x4 w; w.x = cvt_pk_bf16(y[0] * ep_sigmoid(v0[0]), y[1] * ep_sigmoid(v0[1])); w.y = cvt_pk_bf16(y[2] * ep_sigmoid(v0[2]), y[3] * ep_sigmoid(v0[3]));
                    w.z = cvt_pk_bf16(y[4] * ep_sigmoid(v1[0]), y[5] * ep_sigmoid(v1[1])); w.w = cvt_pk_bf16(y[6] * ep_sigmoid(v1[2]), y[7] * ep_sigmoid(v1[3]));
                    *(u32x4*)(O + r * ldo + c) = w; } }
    }
};
template <class Epi, class Sched, bool ALIGN_EPI = false, bool SP2 = false>
__device__ __forceinline__ void gemm_phase(PG8_LAS unsigned char* lds, const Gemm g, const Sched& S, const Epi& E) {
    int tid_ = threadIdx.x; asm volatile("" : "+v"(tid_));
    const int tid = tid_, wid = __builtin_amdgcn_readfirstlane(tid >> 6), lane = tid & 63, wr = wid >> 2, wc = wid & 3, fr = lane & 15, fq = lane >> 4;
    const int K = g.K, nt = K / BK;
    unsigned voffA[2], voffB[2];
#pragma unroll
    for (int i = 0; i < 2; ++i) { int R, C; stage_rc(tid * 16 + i * 8192, R, C); const int Rb = Epi::PERM ? ((R & ~31) + perm32(R & 31)) : R;
        voffA[i] = (unsigned)(R * K + C) * 2u; voffB[i] = (unsigned)(Rb * K + C) * 2u; }
    const size_t kstep = (size_t)(BK * 2);
    const size_t hstep = (size_t)HALF * K * 2;
    const size_t tstep = 2 * hstep;
    const unsigned ldsw = (unsigned)wid * 1024u;
    const int aoff = lds_byte(wr * 64 + fr, fq * 8), boff = lds_byte(wc * 32 + fr, fq * 8);
#define PG8_SA(b, h) (((b) * 2 + (h)) * HTB)
#define PG8_SB(b, h) ((4 + (b) * 2 + (h)) * HTB)
#define PG8_STAGE(bufoff, gbase, voff) do { _Pragma("unroll") for (int _i = 0; _i < 2; ++_i) \
        __builtin_amdgcn_global_load_lds((const unsigned*)((const char*)(gbase) + (voff)[_i]), (PG8_LAS unsigned*)(lds + (bufoff) + ldsw + _i * 8192), 16, 0, 0); } while (0)
#define PG8_LDA(dst, b, h) do { _Pragma("unroll") for (int m = 0; m < 4; ++m) _Pragma("unroll") for (int k = 0; k < 2; ++k) dst[m][k] = *(const PG8_LAS bf16x8*)(lds + PG8_SA(b, h) + aoff + m * 2048 + k * 1024); } while (0)
#define PG8_LDB(dst, b, h) do { _Pragma("unroll") for (int n = 0; n < 2; ++n) _Pragma("unroll") for (int k = 0; k < 2; ++k) dst[n][k] = *(const PG8_LAS bf16x8*)(lds + PG8_SB(b, h) + boff + n * 2048 + k * 1024); } while (0)
#define PG8_MMA(ai, bj, At, Bt) do { __builtin_amdgcn_s_setprio(1); _Pragma("unroll") for (int m = 0; m < 4; ++m) _Pragma("unroll") for (int n = 0; n < 2; ++n) _Pragma("unroll") for (int k = 0; k < 2; ++k) \
        acc[ai][bj][m][n] = __builtin_amdgcn_mfma_f32_16x16x32_bf16(Bt[n][k], At[m][k], acc[ai][bj][m][n], 0, 0, 0); __builtin_amdgcn_s_setprio(0); } while (0)
#define PG8_WAIT_V(n) asm volatile("s_waitcnt vmcnt(" #n ")" ::: "memory")
#define PG8_WAIT_L(n) asm volatile("s_waitcnt lgkmcnt(" #n ")" ::: "memory")
#define PG8_BAR __builtin_amdgcn_s_barrier()
#define PG8_SCHED __builtin_amdgcn_sched_barrier(0)
    Unit cur, nxt; int ui = 0;
    if (!S.next(0, cur)) return;
    f32x4 acc[2][2][4][2];
#pragma unroll
    for (int a = 0; a < 2; ++a)
#pragma unroll
        for (int b = 0; b < 2; ++b)
#pragma unroll
            for (int m = 0; m < 4; ++m)
#pragma unroll
                for (int n = 0; n < 2; ++n) acc[a][b][m][n] = (f32x4){0.f, 0.f, 0.f, 0.f};
    bf16x8 At[4][2], B0[2][2], B1[2][2];
    const char* cA = (const char*)g.A + (size_t)cur.pm * tstep; const char* cB = (const char*)g.Bt + (size_t)cur.pn * tstep;
    S.a_ready(cur);
    if constexpr (SP2) {
        PG8_STAGE(PG8_SB(0, 0), cB, voffB); PG8_STAGE(PG8_SB(0, 1), cB + hstep, voffB); PG8_STAGE(PG8_SA(0, 0), cA, voffA); PG8_STAGE(PG8_SA(0, 1), cA + hstep, voffA);
        if (wr == 1) PG8_BAR;
        PG8_WAIT_V(2); PG8_BAR;
        PG8_STAGE(PG8_SB(1, 0), cB + kstep, voffB); PG8_STAGE(PG8_SA(1, 0), cA + kstep, voffA); PG8_STAGE(PG8_SB(1, 1), cB + hstep + kstep, voffB);
        PG8_WAIT_V(6); PG8_BAR;
    } else {
        PG8_STAGE(PG8_SB(0, 0), cB, voffB); PG8_STAGE(PG8_SA(0, 0), cA, voffA); PG8_STAGE(PG8_SB(0, 1), cB + hstep, voffB); PG8_STAGE(PG8_SA(0, 1), cA + hstep, voffA);
        if (wr == 1) PG8_BAR;
        PG8_WAIT_V(4); PG8_BAR;
        PG8_STAGE(PG8_SB(1, 0), cB + kstep, voffB); PG8_STAGE(PG8_SA(1, 0), cA + kstep, voffA); PG8_STAGE(PG8_SB(1, 1), cB + hstep + kstep, voffB);
        PG8_WAIT_V(6); PG8_BAR;
    }
    for (;;) {
        const bool has_next = S.next(ui + 1, nxt);
        const char* nA = has_next ? (const char*)g.A + (size_t)nxt.pm * tstep : cA; const char* nB = has_next ? (const char*)g.Bt + (size_t)nxt.pn * tstep : cB;
        for (int t = 0; t < nt; t += 2) {
            const bool last = (t == nt - 2);
            const char* a1 = cA + (size_t)(t + 1) * kstep;
            const char* a2 = last ? nA : cA + (size_t)(t + 2) * kstep; const char* b2 = last ? nB : cB + (size_t)(t + 2) * kstep;
            const char* a3 = a2 + kstep; const char* b3 = b2 + kstep;
            if (last && has_next) S.a_ready(nxt);
            if constexpr (SP2) {
            PG8_LDB(B0, 0, 0); PG8_LDB(B1, 0, 1); PG8_SCHED; PG8_LDA(At, 0, 0); PG8_STAGE(PG8_SA(1, 1), a1 + hstep, voffA);
            PG8_WAIT_V(8); PG8_WAIT_L(0); PG8_BAR; PG8_MMA(0, 0, At, B0); PG8_MMA(0, 1, At, B1); PG8_BAR; PG8_SCHED;
            PG8_LDA(At, 0, 1); PG8_STAGE(PG8_SB(0, 0), b2, voffB); PG8_STAGE(PG8_SB(0, 1), b2 + hstep, voffB); PG8_STAGE(PG8_SA(0, 0), a2, voffA);
            PG8_WAIT_V(8); PG8_WAIT_L(0); PG8_BAR; PG8_MMA(1, 0, At, B0); PG8_MMA(1, 1, At, B1); PG8_BAR; PG8_SCHED;
            PG8_LDB(B0, 1, 0); PG8_LDB(B1, 1, 1); PG8_SCHED; PG8_LDA(At, 1, 0); PG8_STAGE(PG8_SA(0, 1), a2 + hstep, voffA);
            PG8_WAIT_V(8); PG8_WAIT_L(0); PG8_BAR; PG8_MMA(0, 0, At, B0); PG8_MMA(0, 1, At, B1); PG8_BAR; PG8_SCHED;
            PG8_LDA(At, 1, 1); PG8_STAGE(PG8_SB(1, 0), b3, voffB); PG8_STAGE(PG8_SB(1, 1), b3 + hstep, voffB); PG8_STAGE(PG8_SA(1, 0), a3, voffA);
            PG8_WAIT_V(8); PG8_WAIT_L(0); PG8_BAR; PG8_MMA(1, 0, At, B0); PG8_MMA(1, 1, At, B1); PG8_BAR; PG8_SCHED;
            } else {
            PG8_LDB(B0, 0, 0); PG8_SCHED; PG8_LDA(At, 0, 0); PG8_STAGE(PG8_SA(1, 1), a1 + hstep, voffA);
            PG8_WAIT_L(8); PG8_BAR; PG8_WAIT_L(0); PG8_MMA(0, 0, At, B0); PG8_BAR; PG8_SCHED;
            PG8_LDB(B1, 0, 1); PG8_STAGE(PG8_SB(0, 0), b2, voffB);
            PG8_BAR; PG8_WAIT_L(0); PG8_MMA(0, 1, At, B1); PG8_BAR;
            PG8_LDA(At, 0, 1); PG8_STAGE(PG8_SA(0, 0), a2, voffA);
            PG8_BAR; PG8_WAIT_L(0); PG8_MMA(1, 0, At, B0); PG8_BAR; PG8_SCHED;
            PG8_STAGE(PG8_SB(0, 1), b2 + hstep, voffB);
            PG8_WAIT_V(6); PG8_BAR; PG8_MMA(1, 1, At, B1); PG8_BAR;
            PG8_LDB(B0, 1, 0); PG8_SCHED; PG8_LDA(At, 1, 0); PG8_STAGE(PG8_SA(0, 1), a2 + hstep, voffA);
            PG8_WAIT_L(8); PG8_BAR; PG8_WAIT_L(0); PG8_MMA(0, 0, At, B0); PG8_BAR; PG8_SCHED;
            PG8_LDB(B1, 1, 1); PG8_STAGE(PG8_SB(1, 0), b3, voffB);
            PG8_BAR; PG8_WAIT_L(0); PG8_MMA(0, 1, At, B1); PG8_BAR;
            PG8_LDA(At, 1, 1); PG8_STAGE(PG8_SA(1, 0), a3, voffA);
            PG8_BAR; PG8_WAIT_L(0); PG8_MMA(1, 0, At, B0); PG8_BAR; PG8_SCHED;
            PG8_STAGE(PG8_SB(1, 1), b3 + hstep, voffB);
            PG8_WAIT_V(6); PG8_BAR; PG8_MMA(1, 1, At, B1); PG8_BAR;
            }
        }
        if constexpr (ALIGN_EPI) { if (wr == 0) PG8_BAR; }
        if constexpr (!Epi::AFTER_DRAIN) { E(acc, cur, wr, wc, fr, fq); S.done(cur); }
        if (!has_next) break;
#pragma unroll
        for (int a = 0; a < 2; ++a)
#pragma unroll
            for (int b = 0; b < 2; ++b)
#pragma unroll
                for (int m = 0; m < 4; ++m)
#pragma unroll
                    for (int n = 0; n < 2; ++n) acc[a][b][m][n] = (f32x4){0.f, 0.f, 0.f, 0.f};
        cur = nxt; cA = nA; cB = nB; ++ui;
        if constexpr (ALIGN_EPI) { if (wr == 1) PG8_BAR; }
    }
    PG8_WAIT_V(0);
    if constexpr (!ALIGN_EPI) { if (wr == 0) PG8_BAR; }
    PG8_BAR;
    if constexpr (Epi::AFTER_DRAIN) { E.fused(acc, cur, wr, wc, fr, fq, lds, wid, lane); S.done(cur); }
#undef PG8_SA
#undef PG8_SB
#undef PG8_STAGE
#undef PG8_LDA
#undef PG8_LDB
#undef PG8_MMA
#undef PG8_WAIT_V
#undef PG8_WAIT_L
#undef PG8_BAR
#undef PG8_SCHED
}
}

#define DI __device__ __forceinline__
#define LAS __attribute__((address_space(3)))
typedef unsigned short bf16;
typedef unsigned v4u __attribute__((ext_vector_type(4)));
typedef unsigned v2u __attribute__((ext_vector_type(2)));
typedef float f32x4 __attribute__((ext_vector_type(4)));
typedef float f32x2 __attribute__((ext_vector_type(2)));
typedef short bf16x8 __attribute__((ext_vector_type(8)));

constexpr int NWAVES = 8, NTHR = 512;
constexpr int BATCH = 2, SEQ = 8192, T = BATCH * SEQ, D = 2048, FF = 5632;
constexpr int AB_N = 6144, AB_LD = 6160, CD_N = 4096, CD_LD = 4128;
constexpr float EPS = 1e-6f;
constexpr size_t MiB = 1u << 20;
constexpr size_t WS_GATES = 1 * MiB, WS_AGG = 3 * MiB, WS_CAR = 5 * MiB, WS_WGT = 6 * MiB;
constexpr size_t WS_GU = 8 * MiB  , WS_DN = 96 * MiB  , WS_MIN = 140 * MiB, WS_MOUT = 164 * MiB, WS_GLU = 172 * MiB, WS_LRUW = 174 * MiB;
constexpr size_t WS_HN = 176 * MiB, WS_YMIX = 240 * MiB, WS_BIG = 304 * MiB, WS_GP = 496 * MiB, WS_HF = 624 * MiB, WS_HB = 656 * MiB, WS_END = 688 * MiB;
constexpr int LDS_BYTES = 147456;

DI float bflo(unsigned w) { return __uint_as_float(w << 16); }
DI float bfhi(unsigned w) { return __uint_as_float(w & 0xffff0000u); }
DI float bf2f(bf16 h) { return __uint_as_float(((unsigned)h) << 16); }
DI unsigned pk2(float lo, float hi) { return pg8::cvt_pk_bf16(lo, hi); }
DI bf16 f2bf(float f) { return (bf16)(pk2(f, 0.f) & 0xffffu); }
DI float sigm(float x) { return __builtin_amdgcn_rcpf(1.0f + __expf(-x)); }
DI float softplus_(float x) { return fmaxf(x, 0.f) + log1pf(__expf(-fabsf(x))); }
DI float logsigmoid_(float x) { return fminf(x, 0.f) - __logf(1.0f + __expf(-fabsf(x))); }
DI float gelu_tanh(float x) { const float u = 0.7978845608028654f * (x + 0.044715f * x * x * x); return x * sigm(2.0f * u); }
DI float wave_sum(float v) {
#pragma unroll
    for (int o = 1; o < 64; o <<= 1) v += __shfl_xor(v, o);
    return v;
}
DI f32x4 mfma16(bf16x8 a, bf16x8 b, f32x4 c) { return __builtin_amdgcn_mfma_f32_16x16x32_bf16(a, b, c, 0, 0, 0); }
template <int KT> DI f32x4 mm16(const LAS bf16* A, int lda, const LAS bf16* B, int ldb, f32x4 acc, int lane) {
    const LAS bf16* a = A + (lane & 15) * lda + (lane >> 4) * 8;
    const LAS bf16* b = B + (lane & 15) * ldb + (lane >> 4) * 8;
#pragma unroll
    for (int k = 0; k < KT; ++k) acc = mfma16(*(const LAS bf16x8*)(a + 32 * k), *(const LAS bf16x8*)(b + 32 * k), acc);
    return acc;
}

#ifndef DBG_SKIP
#define DBG_SKIP 0
#endif
#ifndef DBG_DUP
#define DBG_DUP 0
#endif
#ifndef DBG_XSYNC
#define DBG_XSYNC 0
#endif
#define REP(bit) for (int rep_ = 0; rep_ < ((DBG_DUP & (bit)) ? 2 : 1); ++rep_, __syncthreads())
template <int KT> DI f32x4 mm16_ones(const LAS bf16* A, int lda, int lane) {
    const LAS bf16* a = A + (lane & 15) * lda + (lane >> 4) * 8; f32x4 acc = (f32x4){0.f, 0.f, 0.f, 0.f};
    const bf16x8 ones = {0x3F80, 0x3F80, 0x3F80, 0x3F80, 0x3F80, 0x3F80, 0x3F80, 0x3F80};
#pragma unroll
    for (int k = 0; k < KT; ++k) acc = mfma16(*(const LAS bf16x8*)(a + 32 * k), ones, acc);
    return acc;
}
struct Ctx { LAS unsigned char* lds; int tid, lane, wave, gw, ngw; };

#define RLX_AGENT __ATOMIC_RELAXED, __HIP_MEMORY_SCOPE_AGENT
#define XB_TMO      128
#define XB_XCNT(j)  (256  + 64 * (j))
#define XB_XSUB(j)  (1280 + 64 * (j))
#define XB_XGEN(j)  (2304 + 64 * (j))
#define XB_TOP      3328
#define XB_TOPGEN   3392
#define XCD_BAR_WORDS 3456
#define XB_SPIN_CAP (1u << 18)

__device__ __forceinline__ unsigned xb_ld(unsigned* p)              { return __hip_atomic_load(p, __ATOMIC_RELAXED, __HIP_MEMORY_SCOPE_AGENT); }
__device__ __forceinline__ unsigned xb_add(unsigned* p, unsigned v) { return __hip_atomic_fetch_add(p, v, __ATOMIC_RELAXED, __HIP_MEMORY_SCOPE_AGENT); }
__device__ __forceinline__ unsigned xb_xcc_id() { return (unsigned)__builtin_amdgcn_s_getreg((3 << 11) | 20) & 0xFu; }
#define XB_SPIN(cond, bar) do { unsigned _sp = 0; while (cond) { __builtin_amdgcn_s_sleep(1); \
    if ((++_sp & 255u) == 0u) { if (xb_ld(&(bar)[XB_TMO])) break; if (_sp > XB_SPIN_CAP) { atomicAdd(&(bar)[XB_TMO], 1u); break; } } } } while (0)

struct XcdBarrier {
    unsigned* bar; unsigned x;
    volatile LAS unsigned* st;
};

__device__ __forceinline__ XcdBarrier xcd_barrier_post(unsigned* bar, volatile LAS unsigned* st) {
    XcdBarrier b; b.bar = bar; b.x = xb_xcc_id(); b.st = st;
    if (threadIdx.x == 0) (void)xb_add(&bar[XB_XCNT(b.x)], 1u);
    return b;
}
__device__ __forceinline__ void xcd_barrier_complete(unsigned* bar, unsigned x, unsigned& nloc, unsigned& nx) {
    const unsigned G = gridDim.x * gridDim.y * gridDim.z;
    unsigned sum, cnt, mine, sp = 0u;
    for (;;) {
        sum = 0u; cnt = 0u; mine = 0u;
#pragma unroll
        for (unsigned j = 0; j < 16; ++j) { const unsigned c = xb_ld(&bar[XB_XCNT(j)]); sum += c; cnt += (c > 0u) ? 1u : 0u; mine = (j == x) ? c : mine; }
        if (sum == G) break;
        __builtin_amdgcn_s_sleep(1);
        if ((++sp & 255u) == 0u) { if (xb_ld(&bar[XB_TMO])) break; if (sp > XB_SPIN_CAP) { atomicAdd(&bar[XB_TMO], 1u); break; } }
    }
    nloc = mine > 0u ? mine : 1u; nx = cnt > 0u ? cnt : 1u;
}

__device__ __forceinline__ void xcd_barrier(const XcdBarrier& b) {
    asm volatile("s_waitcnt vmcnt(0)" ::: "memory");
    __syncthreads();
    if (threadIdx.x == 0) {
        unsigned* bar = b.bar;
        __builtin_amdgcn_s_waitcnt(0);
        unsigned nloc = b.st[0], nx = b.st[1];
        if (nloc == 0u) { xcd_barrier_complete(bar, b.x, nloc, nx); b.st[0] = nloc; b.st[1] = nx; }
        const unsigned old = xb_add(&bar[XB_XSUB(b.x)], 1u);
        const unsigned gen = old / nloc;
        if (old + 1u == (gen + 1u) * nloc) {
            __builtin_amdgcn_fence(__ATOMIC_RELEASE, "agent");
            asm volatile("s_waitcnt vmcnt(0)" ::: "memory");
            const unsigned og = xb_add(&bar[XB_TOP], 1u);
            const unsigned tg = og / nx;
            if (og + 1u == (tg + 1u) * nx) xb_add(&bar[XB_TOPGEN], 1u);
            else XB_SPIN(xb_ld(&bar[XB_TOPGEN]) == tg, bar);
            __builtin_amdgcn_fence(__ATOMIC_ACQUIRE, "agent");
            xb_add(&bar[XB_XGEN(b.x)], 1u);
            asm volatile("s_waitcnt vmcnt(0)" ::: "memory");
        } else {
            XB_SPIN(xb_ld(&bar[XB_XGEN(b.x)]) == gen, bar);
            __builtin_amdgcn_fence(__ATOMIC_ACQUIRE, "agent");
            asm volatile("s_waitcnt vmcnt(0)" ::: "memory");
        }
    }
    __syncthreads();
}


DI void half_barrier(unsigned* cnt, unsigned n) {
    asm volatile("s_waitcnt vmcnt(0)" ::: "memory"); __syncthreads();
    if (threadIdx.x == 0) {
        __builtin_amdgcn_fence(__ATOMIC_RELEASE, "agent"); asm volatile("s_waitcnt vmcnt(0)" ::: "memory");
        (void)xb_add(cnt, 1u);
        unsigned sp = 0u; while (xb_ld(cnt) < n) { __builtin_amdgcn_s_sleep(1); if (++sp > (1u << 22)) break; }
        __builtin_amdgcn_fence(__ATOMIC_ACQUIRE, "agent"); asm volatile("s_waitcnt vmcnt(0)" ::: "memory");
    }
    __syncthreads();
}
DI void transpose_item(const float* W, int ldw, int k0, int nsrc, bf16* WT, int K, int drow, LAS float* scr, int lane) {
    float tv[32];
#pragma unroll
    for (int i = 0; i < 32; ++i) { const int kk = 2 * i + (lane >> 5); tv[i] = __builtin_nontemporal_load(W + (size_t)(k0 + kk) * ldw + nsrc + (lane & 31)); }
#pragma unroll
    for (int i = 0; i < 32; ++i) { const int kk = 2 * i + (lane >> 5); scr[kk * 33 + (lane & 31)] = tv[i]; }
    asm volatile("s_waitcnt lgkmcnt(0)" ::: "memory");
    const int c = lane & 7;
#pragma unroll
    for (int j = 0; j < 4; ++j) { const int n = (lane >> 3) + 8 * j; const LAS float* s = scr + (8 * c) * 33 + n;
        v4u o; o.x = pk2(s[0 * 33], s[1 * 33]); o.y = pk2(s[2 * 33], s[3 * 33]); o.z = pk2(s[4 * 33], s[5 * 33]); o.w = pk2(s[6 * 33], s[7 * 33]);
        *(v4u*)(WT + (size_t)(drow + n) * K + k0 + 8 * c) = o; }
    asm volatile("s_waitcnt lgkmcnt(0)" ::: "memory");
}
DI void conv_plain(const Ctx& C, const float* W, int ldw, int K, int N, int src_skip_at, int src_skip, bf16* WT) {
    LAS float* scr = (LAS float*)(C.lds + C.wave * 16384);
    const int nb = N / 32, items = (K / 64) * nb;
    for (int it = C.gw; it < items; it += C.ngw) { const int kb = it / nb, n0 = 32 * (it % nb);
        transpose_item(W, ldw, 64 * kb, n0 < src_skip_at ? n0 : n0 + src_skip, WT, K, n0, scr, C.lane); }
}
DI void conv_gu(const Ctx& C, const float* W, bf16* WT) {
    LAS float* scr = (LAS float*)(C.lds + C.wave * 16384);
    constexpr int nb = 2 * FF / 32, items = (D / 64) * nb;
    for (int it = C.gw; it < items; it += C.ngw) { const int kb = it / nb, n0 = 32 * (it % nb);
        const int j = n0 < FF ? n0 : n0 - FF; const int drow = 256 * (j >> 7) + (n0 < FF ? 0 : 128) + (j & 127);
        transpose_item(W, 2 * FF, 64 * kb, n0, WT, D, drow, scr, C.lane); }
}
DI void conv_small(const Ctx& C, const float* W, int ldw, int col0, int nc, bf16* WT) {
    const int gt = C.gw * 64 + C.lane, ngt = C.ngw * 64;
    for (int i = gt; i < nc * D; i += ngt) { const int c = i / D, k = i % D; WT[i] = f2bf(W[(size_t)k * ldw + col0 + c]); }
}

DI void rms_rows_bf16(const Ctx& C, const float* x, const float* g, bf16* out) {
    for (int m = C.gw; m < T; m += C.ngw) {
        const f32x4* xr = (const f32x4*)(x + (size_t)m * D) + C.lane; f32x4 v[8]; float s = 0.f;
#pragma unroll
        for (int j = 0; j < 8; ++j) { v[j] = xr[64 * j]; s += (v[j].x * v[j].x + v[j].y * v[j].y) + (v[j].z * v[j].z + v[j].w * v[j].w); }
        const float rstd = 1.0f / sqrtf(wave_sum(s) * (1.0f / D) + EPS);
        const f32x4* gr = (const f32x4*)g + C.lane; v2u* o = (v2u*)(out + (size_t)m * D) + C.lane;
#pragma unroll
        for (int j = 0; j < 8; ++j) { const f32x4 gv = gr[64 * j]; v2u w; w.x = pk2(v[j].x * rstd * gv.x, v[j].y * rstd * gv.y); w.y = pk2(v[j].z * rstd * gv.z, v[j].w * rstd * gv.w); o[64 * j] = w; }
    }
}
DI void rms_rows_f32(const Ctx& C, float* x, const float* g) {
    for (int m = C.gw; m < T; m += C.ngw) {
        f32x4* xr = (f32x4*)(x + (size_t)m * D) + C.lane; f32x4 v[8]; float s = 0.f;
#pragma unroll
        for (int j = 0; j < 8; ++j) { v[j] = xr[64 * j]; s += (v[j].x * v[j].x + v[j].y * v[j].y) + (v[j].z * v[j].z + v[j].w * v[j].w); }
        const float rstd = 1.0f / sqrtf(wave_sum(s) * (1.0f / D) + EPS);
        const f32x4* gr = (const f32x4*)g + C.lane;
#pragma unroll
        for (int j = 0; j < 8; ++j) { const f32x4 gv = gr[64 * j]; xr[64 * j] = v[j] * rstd * gv; }
    }
}

template <int NT> DI void gate_gemm(const Ctx& C, const bf16* HN, const bf16* WgT, const float* bias, float* G, const pg8::rowss_t* rowss) {
    const int lane = C.lane;
    for (int rt = C.gw; rt < T / 16; rt += C.ngw) {
        f32x4 acc[NT];
#pragma unroll
        for (int n = 0; n < NT; ++n) acc[n] = (f32x4){0.f, 0.f, 0.f, 0.f};
        const bf16* a = HN + (size_t)(rt * 16 + (lane & 15)) * D + (lane >> 4) * 8;
        const bf16* b = WgT + (size_t)(lane & 15) * D + (lane >> 4) * 8;
#pragma unroll 4
        for (int k = 0; k < D / 32; ++k) { const bf16x8 av = *(const bf16x8*)(a + 32 * k);
#pragma unroll
            for (int n = 0; n < NT; ++n) acc[n] = mfma16(av, *(const bf16x8*)(b + (size_t)n * 16 * D + 32 * k), acc[n]); }
#pragma unroll
        for (int n = 0; n < NT; ++n)
#pragma unroll
            for (int j = 0; j < 4; ++j) { const int row = rt * 16 + (lane >> 4) * 4 + j, col = n * 16 + (lane & 15); G[(size_t)row * (16 * NT) + col] = acc[n][j] * pg8::ep_rstd(rowss, row) + (bias ? bias[col] : 0.f); }
    }
}

DI void lru_gate_phase(const Ctx& C, const bf16* PROJ, const float* conv_w, const float* conv_b, const bf16* LW, const float* gate_b, const float* lam, bf16* LA, bf16* BV) {
    LAS bf16* XC = (LAS bf16*)C.lds;
    LAS float* XF = (LAS float*)(C.lds + 17408);
    const int tid = C.tid, lane = C.lane, w = C.wave;
    for (int item = C.gw / NWAVES; item < (T / 64) * 8; item += C.ngw / NWAVES) {
        const int h = item & 7, tok0 = (item >> 3) * 64;
        {
            const int r = tid >> 3, cs = tid & 7, c0 = h * 128 + cs * 16, tok = tok0 + r, ts = tok & (SEQ - 1);
            float a[16];
#pragma unroll
            for (int i = 0; i < 16; ++i) a[i] = conv_b[c0 + i];
#pragma unroll
            for (int k = 0; k < 4; ++k) { const int tk = ts + k - 2;
                if (tk >= 0 && tk < SEQ) { const v4u* p = (const v4u*)(PROJ + (size_t)(tok + k - 2) * AB_N + c0); const v4u x0 = p[0], x1 = p[1]; const float* wk = conv_w + k * 1024 + c0;
                    a[0] += wk[0] * bflo(x0.x); a[1] += wk[1] * bfhi(x0.x); a[2] += wk[2] * bflo(x0.y); a[3] += wk[3] * bfhi(x0.y); a[4] += wk[4] * bflo(x0.z); a[5] += wk[5] * bfhi(x0.z); a[6] += wk[6] * bflo(x0.w); a[7] += wk[7] * bfhi(x0.w);
                    a[8] += wk[8] * bflo(x1.x); a[9] += wk[9] * bfhi(x1.x); a[10] += wk[10] * bflo(x1.y); a[11] += wk[11] * bfhi(x1.y); a[12] += wk[12] * bflo(x1.z); a[13] += wk[13] * bfhi(x1.z); a[14] += wk[14] * bflo(x1.w); a[15] += wk[15] * bfhi(x1.w); } }
            v4u o0, o1; o0.x = pk2(a[0], a[1]); o0.y = pk2(a[2], a[3]); o0.z = pk2(a[4], a[5]); o0.w = pk2(a[6], a[7]); o1.x = pk2(a[8], a[9]); o1.y = pk2(a[10], a[11]); o1.z = pk2(a[12], a[13]); o1.w = pk2(a[14], a[15]);
            *(LAS v4u*)(XC + r * 136 + cs * 16) = o0; *(LAS v4u*)(XC + r * 136 + cs * 16 + 8) = o1;
#pragma unroll
            for (int i = 0; i < 4; ++i) *(LAS f32x4*)(XF + r * 132 + cs * 16 + 4 * i) = (f32x4){a[4 * i], a[4 * i + 1], a[4 * i + 2], a[4 * i + 3]};
        }
        __syncthreads();
        const int j0 = 16 * w, ch = h * 128 + j0 + (lane & 15);
        bf16x8 bfr[4][4];
#pragma unroll
        for (int g = 0; g < 4; ++g)
#pragma unroll
            for (int k = 0; k < 4; ++k) bfr[g][k] = *(const bf16x8*)(LW + ((size_t)(g * 8 + h) * 128 + j0 + (lane & 15)) * 128 + k * 32 + (lane >> 4) * 8);
        float gb[4], sp[2]; bf16* lap = LA + (size_t)tok0 * 1024 + ch; bf16* bvp = BV + (size_t)tok0 * 1024 + ch;
#pragma unroll
        for (int g = 0; g < 4; ++g) gb[g] = gate_b[g * 1024 + ch];
        sp[0] = softplus_(-lam[ch]); sp[1] = softplus_(-lam[1024 + ch]);
#pragma unroll 1
        for (int rt = 0; rt < 4; ++rt) {
            f32x4 acc[4];
#pragma unroll
            for (int g = 0; g < 4; ++g) acc[g] = (f32x4){0.f, 0.f, 0.f, 0.f};
#pragma unroll
            for (int k = 0; k < 4; ++k) { const bf16x8 av = *(const LAS bf16x8*)(XC + (16 * rt + (lane & 15)) * 136 + k * 32 + (lane >> 4) * 8);
#pragma unroll
                for (int g = 0; g < 4; ++g) acc[g] = mfma16(av, bfr[g][k], acc[g]); }
#pragma unroll
            for (int j = 0; j < 4; ++j) { const int t = 16 * rt + (lane >> 4) * 4 + j; const float xv = XF[t * 132 + j0 + (lane & 15)];
#pragma unroll
                for (int dir = 0; dir < 2; ++dir) { const float r = sigm(acc[dir * 2][j] + gb[dir * 2]), ii = sigm(acc[dir * 2 + 1][j] + gb[dir * 2 + 1]);
                    const float la = -8.0f * r * sp[dir]; const float x2 = 2.0f * la;
                    const float om = x2 > -0.3f ? -x2 * (1.0f + x2 * (0.5f + x2 * (0.16666667f + x2 * (0.041666668f + x2 * 0.008333334f)))) : 1.0f - __expf(x2);
                    const float bv = __builtin_amdgcn_sqrtf(om) * ii * xv; const unsigned o = (unsigned)dir * (unsigned)(T * 1024) + (unsigned)t * 1024u;
                    lap[o] = f2bf(la); bvp[o] = f2bf(bv); } }
        }
        __syncthreads();
    }
}
constexpr int LSEG = 128, LNSEG = SEQ / LSEG;
DI void lru_pass1(const Ctx& C, const bf16* LA, const bf16* BV, f32x2* AGG) {
    const int gt = (C.gw / NWAVES) * NTHR + C.tid, ngt = (C.ngw / NWAVES) * NTHR;
    for (int idx = gt; idx < BATCH * 2 * LNSEG * 512; idx += ngt) {
        const int ch = (idx & 511) * 2, sl = (idx >> 9) & (LNSEG - 1), dir = (idx >> 15) & 1, b = idx >> 16;
        float A0 = 1.f, H0 = 0.f, A1 = 1.f, H1 = 0.f;
        const size_t base = ((size_t)dir * T + (size_t)b * SEQ) * 1024 + ch;
#pragma unroll 16
        for (int i = 0; i < LSEG; ++i) { const int li = sl * LSEG + i, t = dir ? SEQ - 1 - li : li; const unsigned o = (unsigned)t * 1024u;
            const unsigned lw = *(const unsigned*)(LA + base + o), bw = *(const unsigned*)(BV + base + o);
            const float a0 = __expf(bflo(lw)), a1 = __expf(bfhi(lw)); A0 *= a0; H0 = a0 * H0 + bflo(bw); A1 *= a1; H1 = a1 * H1 + bfhi(bw); }
        *(f32x4*)(AGG + ((size_t)((b * 2 + dir) * LNSEG + sl)) * 1024 + ch) = (f32x4){A0, H0, A1, H1};
    }
}
DI void lru_pass3(const Ctx& C, const bf16* LA, const bf16* BV, const f32x2* AGG, const bf16* PROJ, float* HT, bf16* YMIX) {
    const int gt = (C.gw / NWAVES) * NTHR + C.tid, ngt = (C.ngw / NWAVES) * NTHR;
    for (int idx = gt; idx < BATCH * LNSEG * 512; idx += ngt) {
        const int ch = (idx & 511) * 2, seg = (idx >> 9) & (LNSEG - 1), b = idx >> 15;
        float h0 = 0.f, h1 = 0.f;
#pragma unroll 8
        for (int s = 0; s < seg; ++s) { const f32x4 e = *(const f32x4*)(AGG + ((size_t)((b * 2 + 0) * LNSEG + s)) * 1024 + ch); h0 = e.x * h0 + e.y; h1 = e.z * h1 + e.w; }
        const size_t tok0 = (size_t)b * SEQ + seg * LSEG; const bf16* la0 = LA + tok0 * 1024 + ch; const bf16* bv0 = BV + tok0 * 1024 + ch; bf16* yp = YMIX + tok0 * D + ch;
#pragma unroll 16
        for (int i = 0; i < LSEG; ++i) { const unsigned lw = *(const unsigned*)(la0 + i * 1024), bw = *(const unsigned*)(bv0 + i * 1024);
            h0 = __expf(bflo(lw)) * h0 + bflo(bw); h1 = __expf(bfhi(lw)) * h1 + bfhi(bw); *(unsigned*)(yp + i * D) = pk2(h0, h1); }
        h0 = 0.f; h1 = 0.f;
#pragma unroll 8
        for (int s = 0; s < LNSEG - 1 - seg; ++s) { const f32x4 e = *(const f32x4*)(AGG + ((size_t)((b * 2 + 1) * LNSEG + s)) * 1024 + ch); h0 = e.x * h0 + e.y; h1 = e.z * h1 + e.w; }
        const bf16* la1 = la0 + (size_t)T * 1024; const bf16* bv1 = bv0 + (size_t)T * 1024; const bf16* gp = PROJ + tok0 * AB_N + 1024 + ch;
#pragma unroll 16
        for (int i = LSEG - 1; i >= 0; --i) { const unsigned lw = *(const unsigned*)(la1 + i * 1024), bw = *(const unsigned*)(bv1 + i * 1024), gw = *(const unsigned*)(gp + (size_t)i * AB_N), fw = *(const unsigned*)(yp + i * D);
            h0 = __expf(bflo(lw)) * h0 + bflo(bw); h1 = __expf(bfhi(lw)) * h1 + bfhi(bw);
            *(unsigned*)(yp + i * D) = pk2(gelu_tanh(bflo(gw)) * (bflo(fw) + h0), gelu_tanh(bfhi(gw)) * (bfhi(fw) + h1)); }
    }
}

template <int ACT  > DI void hnorm_phase(const Ctx& C, const bf16* HF, const bf16* HB, const float* g, const bf16* gate, int ldg, bf16* Y  ) {
    for (int it = C.gw; it < T * 4; it += C.ngw) { const int tok = it >> 2, h = it & 3; const size_t o = (size_t)tok * 1024 + h * 256 + 4 * C.lane;
        const v2u a = *(const v2u*)(HF + o), b = *(const v2u*)(HB + o);
        float v[4] = {bflo(a.x) + bflo(b.x), bfhi(a.x) + bfhi(b.x), bflo(a.y) + bflo(b.y), bfhi(a.y) + bfhi(b.y)};
        const float rstd = 1.0f / sqrtf(wave_sum((v[0] * v[0] + v[1] * v[1]) + (v[2] * v[2] + v[3] * v[3])) * (1.0f / 256.0f) + EPS);
        const f32x4 gv = *(const f32x4*)(g + h * 256 + 4 * C.lane); const v2u gt = *(const v2u*)(gate + (size_t)tok * ldg + h * 256 + 4 * C.lane);
        float z[4] = {bflo(gt.x), bfhi(gt.x), bflo(gt.y), bfhi(gt.y)}, r[4];
#pragma unroll
        for (int i = 0; i < 4; ++i) { const float s = sigm(z[i]); r[i] = v[i] * rstd * gv[i] * (ACT == 0 ? s : z[i] * s); }
        v2u w; w.x = pk2(r[0], r[1]); w.y = pk2(r[2], r[3]); *(v2u*)(Y + (size_t)tok * D + h * 256 + 4 * C.lane) = w; }
}

#define TOKOF(c, l) ((size_t)b * SEQ + (size_t)(dir ? SEQ - 1 - ((c) * 64 + (l)) : ((c) * 64 + (l))))
DI float wave_incl_add(float v, int lane) {
#pragma unroll
    for (int o = 1; o < 64; o <<= 1) { const float t = __shfl_up(v, o); if (lane >= o) v += t; }
    return v;
}
DI float wave_incl_max(float v, int lane) {
#pragma unroll
    for (int o = 1; o < 64; o <<= 1) { const float t = __shfl_up(v, o); if (lane >= o) v = fmaxf(v, t); }
    return v;
}
#define LBAR() do { asm volatile("s_waitcnt lgkmcnt(0)" ::: "memory"); __builtin_amdgcn_s_barrier(); asm volatile("" ::: "memory"); } while (0)
DI void mlstm_pre(const Ctx& C, const bf16* PROJ, const float* GATES, f32x4* TAB, bf16* PP) {
    constexpr int LQ = 264, LT = 72;
    LAS bf16* Qs = (LAS bf16*)(C.lds); LAS bf16* Ks = (LAS bf16*)(C.lds + 33792); LAS float* sg = (LAS float*)(C.lds + 67584); LAS float* spm = sg + 64; LAS bf16* Ps = (LAS bf16*)(C.lds + 68096);
    const int tid = C.tid, lane = C.lane, w = C.wave; const float scale = 0.0625f;
    for (int item = blockIdx.x; item < 16 * (SEQ / 64); item += gridDim.x) {
        const int c = item & 127, chain = item >> 7, dir = chain & 1, h = (chain >> 1) & 3, b = chain >> 3;
        if (w == 0) { const size_t tok = TOKOF(c, lane); const float ig = GATES[tok * 16 + dir * 8 + h], fg = GATES[tok * 16 + dir * 8 + 4 + h];
            const float cum = wave_incl_add(logsigmoid_(fg), lane); const float g = ig - cum; const float pm = wave_incl_max(g, lane);
            TAB[(size_t)item * 64 + lane] = (f32x4){g, cum, pm, 0.f}; sg[lane] = g; spm[lane] = pm; }
#pragma unroll
        for (int i = 0; i < 4; ++i) { const int idx = tid + NTHR * i, row = idx >> 5, cc = idx & 31; const bf16* p = PROJ + TOKOF(c, row) * AB_N + h * 256 + 8 * cc;
            *(LAS v4u*)(Qs + row * LQ + 8 * cc) = *(const v4u*)(p + 2048); *(LAS v4u*)(Ks + row * LQ + 8 * cc) = *(const v4u*)(p + 3072); }
        __syncthreads();
#pragma unroll
        for (int q = 0; q < 2; ++q) { const int ti = 2 * w + q, tr = ti >> 2, tc = ti & 3;
            if (tc <= tr) { const f32x4 acc = mm16<8>(Qs + 16 * tr * LQ, LQ, Ks + 16 * tc * LQ, LQ, (f32x4){0.f, 0.f, 0.f, 0.f}, lane);
                const int s = 16 * tc + (lane & 15); const float gs = sg[s];
#pragma unroll
                for (int j = 0; j < 4; ++j) { const int t = 16 * tr + (lane >> 4) * 4 + j; Ps[t * LT + s] = f2bf((s <= t) ? acc[j] * scale * __expf(gs - spm[t]) : 0.f); }
            } else {
#pragma unroll
                for (int j = 0; j < 4; ++j) Ps[(16 * tr + (lane >> 4) * 4 + j) * LT + 16 * tc + (lane & 15)] = 0;
            } }
        __syncthreads();
        { const int row = tid >> 3, cc = tid & 7; *(v4u*)(PP + ((size_t)item * 64 + row) * 64 + 8 * cc) = *(const LAS v4u*)(Ps + row * LT + 8 * cc); }
        __syncthreads();
    }
}
template <bool INSYNC> DI void mlstm_phase(const Ctx& C, const bf16* PROJ, const f32x4* TAB, const bf16* PP, bf16* HF, bf16* HB, const XcdBarrier& xbar) {
    constexpr int LQ = 264, LT = 72;
    LAS bf16* Qs = (LAS bf16*)(C.lds); LAS bf16* KT = (LAS bf16*)(C.lds + 33792); LAS bf16* VT = (LAS bf16*)(C.lds + 70656); LAS bf16* Ps = (LAS bf16*)(C.lds + 75264);
    LAS bf16* ST = (LAS bf16*)(C.lds + 84480); LAS bf16* NB = (LAS bf16*)(C.lds + 101376); LAS float* SC = (LAS float*)(C.lds + 101888);
    LAS float* s_wi = SC, *s_ws = SC + 64, *s_enm = SC + 128, *s_cf = SC + 192, *s_misc = SC + 256;
    const int tid = C.tid, lane = C.lane, w = C.wave;
    const float scale = 0.0625f;
    const bf16x8 ones = {0x3F80, 0x3F80, 0x3F80, 0x3F80, 0x3F80, 0x3F80, 0x3F80, 0x3F80};
    for (int item = blockIdx.x; item < 128; item += gridDim.x) {
        const int chain = (item & 7) * 2 + (item >> 6), eb = (item >> 3) & 7, dir = chain & 1, h = (chain >> 1) & 3, b = chain >> 3;
        bf16* HO = dir ? HB : HF;
        f32x4 Sacc[2][2], nacc[2];
#pragma unroll
        for (int i = 0; i < 2; ++i) { nacc[i] = (f32x4){0.f, 0.f, 0.f, 0.f};
#pragma unroll
            for (int j = 0; j < 2; ++j) Sacc[i][j] = (f32x4){0.f, 0.f, 0.f, 0.f}; }
        float m_st = 0.f;
        for (int i = tid; i < 32 * LQ / 2; i += NTHR) ((LAS unsigned*)ST)[i] = 0u;
        if (tid < 128) ((LAS unsigned*)NB)[tid] = 0u;
        v4u qreg[4], ktr[4], preg; v2u vreg; f32x4 tg = (f32x4){0.f, 0.f, 0.f, 0.f};
#define MLSTM_LOAD(c) do { if (w == 0) tg = TAB[((size_t)chain * 128 + (c)) * 64 + lane]; \
            _Pragma("unroll") for (int i = 0; i < 4; ++i) { const int idx = tid + NTHR * i, row = idx >> 5, cc = idx & 31; qreg[i] = *(const v4u*)(PROJ + TOKOF((c), row) * AB_N + 2048 + h * 256 + 8 * cc); } \
            { const bf16* pt = PROJ + TOKOF((c), lane) * AB_N + h * 256; _Pragma("unroll") for (int i = 0; i < 4; ++i) ktr[i] = *(const v4u*)(pt + 3072 + 32 * w + 8 * i); \
              vreg = *(const v2u*)(pt + 4096 + eb * 32 + 4 * w); } \
            preg = *(const v4u*)(PP + (((size_t)chain * 128 + (c)) * 64 + (tid >> 3)) * 64 + 8 * (tid & 7)); } while (0)
        MLSTM_LOAD(0);
        __syncthreads();
        for (int c = 0; c < SEQ / 64; ++c) {
            if (INSYNC && (c == 43 || c == 86)) xcd_barrier(xbar);
            if (w == 0) { const float g = tg.x, cum = tg.y + tg.w, pm = tg.z;
                const float rr = -fmaxf(pm, m_st); const float gmax = __shfl(pm, 63), tot = __shfl(cum, 63); const float mm = fmaxf(m_st, gmax);
                s_wi[lane] = __expf(m_st + rr); s_ws[lane] = __expf(g - mm); s_enm[lane] = __expf(rr - cum); s_cf[lane] = __expf(pm + rr);
                if (lane == 0) { s_misc[0] = __expf(m_st - mm); s_misc[1] = tot + mm; } }
            LBAR();
            const float wc = s_misc[0]; m_st = s_misc[1];
#pragma unroll
            for (int i = 0; i < 4; ++i) { const int idx = tid + NTHR * i, row = idx >> 5, cc = idx & 31; *(LAS v4u*)(Qs + row * LQ + 8 * cc) = qreg[i]; }
            { const float ws = s_ws[lane];
#pragma unroll
                for (int i = 0; i < 4; ++i) { const v4u k = ktr[i]; LAS bf16* kt = KT + (32 * w + 8 * i) * LT + lane;
                    kt[0 * LT] = f2bf(bflo(k.x) * ws); kt[1 * LT] = f2bf(bfhi(k.x) * ws); kt[2 * LT] = f2bf(bflo(k.y) * ws); kt[3 * LT] = f2bf(bfhi(k.y) * ws);
                    kt[4 * LT] = f2bf(bflo(k.z) * ws); kt[5 * LT] = f2bf(bfhi(k.z) * ws); kt[6 * LT] = f2bf(bflo(k.w) * ws); kt[7 * LT] = f2bf(bfhi(k.w) * ws); }
                LAS bf16* vt = VT + (4 * w) * LT + lane; const v2u v = vreg;
                vt[0 * LT] = (bf16)(v.x & 0xffffu); vt[1 * LT] = (bf16)(v.x >> 16); vt[2 * LT] = (bf16)(v.y & 0xffffu); vt[3 * LT] = (bf16)(v.y >> 16); }
            *(LAS v4u*)(Ps + (tid >> 3) * LT + 8 * (tid & 7)) = preg;
            if (c + 1 < SEQ / 64) MLSTM_LOAD(c + 1);
            LBAR();
            const int fr = lane & 15, fq = lane >> 4;
            bf16x8 vf[2][2];
#pragma unroll
            for (int ct = 0; ct < 2; ++ct)
#pragma unroll
                for (int k = 0; k < 2; ++k) vf[ct][k] = *(const LAS bf16x8*)(VT + (16 * ct + fr) * LT + 32 * k + 8 * fq);
            { const int tr = w >> 1, tc = w & 1;
                f32x4 accO = (f32x4){0.f, 0.f, 0.f, 0.f}, accN = accO, accP = accO, rsum = accO;
#pragma unroll
                for (int k = 0; k < 8; ++k) { const bf16x8 a = *(const LAS bf16x8*)(Qs + (16 * tr + fr) * LQ + 32 * k + 8 * fq);
                    accO = mfma16(a, *(const LAS bf16x8*)(ST + (16 * tc + fr) * LQ + 32 * k + 8 * fq), accO);
                    accN = mfma16(a, *(const LAS bf16x8*)(NB + 32 * k + 8 * fq), accN);
                    if ((k & 1) == 1) __builtin_amdgcn_sched_barrier(0); }
#pragma unroll
                for (int k = 0; k < 2; ++k) { const bf16x8 p = *(const LAS bf16x8*)(Ps + (16 * tr + fr) * LT + 32 * k + 8 * fq);
                    accP = tc ? mfma16(p, vf[1][k], accP) : mfma16(p, vf[0][k], accP); rsum = mfma16(p, ones, rsum); }
#pragma unroll
                for (int j = 0; j < 4; ++j) { const int t = 16 * tr + fq * 4 + j; const float wi = s_wi[t] * scale, cf = s_cf[t];
                    const float num = accO[j] * wi + accP[j] * cf, den = rsum[j] * cf + wi * accN[j];
                    HO[TOKOF(c, t) * 1024 + h * 256 + eb * 32 + 16 * tc + fr] = f2bf(num * __builtin_amdgcn_rcpf(fmaxf(fabsf(den), s_enm[t]))); } }
#pragma unroll
            for (int i = 0; i < 2; ++i) { bf16x8 kf[2];
#pragma unroll
                for (int k = 0; k < 2; ++k) kf[k] = *(const LAS bf16x8*)(KT + (16 * (2 * w + i) + fr) * LT + 32 * k + 8 * fq);
                nacc[i] = nacc[i] * wc; Sacc[i][0] = Sacc[i][0] * wc; Sacc[i][1] = Sacc[i][1] * wc;
#pragma unroll
                for (int k = 0; k < 2; ++k) { Sacc[i][0] = mfma16(kf[k], vf[0][k], Sacc[i][0]); Sacc[i][1] = mfma16(kf[k], vf[1][k], Sacc[i][1]); nacc[i] = mfma16(kf[k], ones, nacc[i]); } }
            LBAR();
#pragma unroll
            for (int i = 0; i < 2; ++i) {
#pragma unroll
                for (int ct = 0; ct < 2; ++ct) { v2u o; o.x = pk2(Sacc[i][ct][0], Sacc[i][ct][1]); o.y = pk2(Sacc[i][ct][2], Sacc[i][ct][3]);
                    *(LAS v2u*)(ST + (16 * ct + fr) * LQ + 16 * (2 * w + i) + fq * 4) = o; }
                if (fr == 0) { v2u o; o.x = pk2(nacc[i][0], nacc[i][1]); o.y = pk2(nacc[i][2], nacc[i][3]); *(LAS v2u*)(NB + 16 * (2 * w + i) + fq * 4) = o; } }
        }
        __syncthreads();
#undef MLSTM_LOAD
    }
}

DI void gla_cum_phase(const Ctx& C, const float* GLR  , const float* w2  , const float* gb  , float* CUM, const bf16* PROJ, bf16* PPG, bf16* QH, bf16* KH) {
    LAS float* low = (LAS float*)C.lds;
    LAS bf16* Qt = (LAS bf16*)(C.lds + 4096); LAS bf16* Kt = (LAS bf16*)(C.lds + 21504); LAS bf16* Ps = (LAS bf16*)(C.lds + 38912);
    const int tid = C.tid, lane = C.lane, w = C.wave;
    for (int item = blockIdx.x; item < BATCH * (SEQ / 64) * 2; item += gridDim.x) {
        const int dir = item & 1, c = (item >> 1) & 127, b = item >> 8;
        __syncthreads();
        for (int i = tid; i < 1024; i += NTHR) { const int l = i >> 4, r = i & 15; const int li = c * 64 + l; const size_t tok = (size_t)b * SEQ + (dir ? SEQ - 1 - li : li); low[i] = GLR[tok * 32 + dir * 16 + r]; }
        __syncthreads();
        float wr[16];
#pragma unroll
        for (int r = 0; r < 16; ++r) wr[r] = w2[(dir * 16 + r) * 512 + tid];
        const float bias = gb[dir * 512 + tid]; float cum = 0.f;
#pragma unroll 4
        for (int l = 0; l < 64; ++l) { float pre = bias;
#pragma unroll
            for (int r4 = 0; r4 < 4; ++r4) { const f32x4 lv = *(const LAS f32x4*)(low + l * 16 + 4 * r4); pre += lv.x * wr[4 * r4] + lv.y * wr[4 * r4 + 1] + lv.z * wr[4 * r4 + 2] + lv.w * wr[4 * r4 + 3]; }
            cum += logsigmoid_(pre) * 0.0625f; const int li = c * 64 + l; const size_t tok = (size_t)b * SEQ + (dir ? SEQ - 1 - li : li);
            CUM[((size_t)dir * T + tok) * 512 + tid] = cum; }
        __syncthreads();
        constexpr int LQ = 136, LT = 72; const float scale = 0.08838834764831845f;
#pragma unroll 1
        for (int h = 0; h < 4; ++h) {
            const float* cref = CUM + ((size_t)dir * T + TOKOF(c, 31)) * 512 + h * 128;
            const float* ctot = CUM + ((size_t)dir * T + TOKOF(c, 63)) * 512 + h * 128; const int chain_ = (b * 4 + h) * 2 + dir;
#pragma unroll
            for (int i = 0; i < 2; ++i) { const int idx = tid + NTHR * i, row = idx >> 4, cc = idx & 15, d0 = 8 * cc; const size_t tok = TOKOF(c, row);
                const v4u qv = *(const v4u*)(PROJ + tok * CD_N + h * 128 + d0), kv = *(const v4u*)(PROJ + tok * CD_N + 512 + h * 128 + d0);
                const float* cp = CUM + ((size_t)dir * T + tok) * 512 + h * 128 + d0;
                const f32x4 c0 = *(const f32x4*)cp, c1 = *(const f32x4*)(cp + 4), r0 = *(const f32x4*)(cref + d0), r1 = *(const f32x4*)(cref + d0 + 4);
                float q[8] = {bflo(qv.x), bfhi(qv.x), bflo(qv.y), bfhi(qv.y), bflo(qv.z), bfhi(qv.z), bflo(qv.w), bfhi(qv.w)};
                float k[8] = {bflo(kv.x), bfhi(kv.x), bflo(kv.y), bfhi(kv.y), bflo(kv.z), bfhi(kv.z), bflo(kv.w), bfhi(kv.w)};
                float cu[8] = {c0.x, c0.y, c0.z, c0.w, c1.x, c1.y, c1.z, c1.w}, cr[8] = {r0.x, r0.y, r0.z, r0.w, r1.x, r1.y, r1.z, r1.w};
                float qt[8], kt[8];
#pragma unroll
                for (int e = 0; e < 8; ++e) { qt[e] = q[e] * scale * __expf(cu[e] - cr[e]); kt[e] = k[e] * __expf(cr[e] - cu[e]); }
                {
                    const f32x4 t0 = *(const f32x4*)(ctot + d0), t1 = *(const f32x4*)(ctot + d0 + 4); const float ct[8] = {t0.x, t0.y, t0.z, t0.w, t1.x, t1.y, t1.z, t1.w};
                    float qh[8], kh[8];
#pragma unroll
                    for (int e = 0; e < 8; ++e) { qh[e] = q[e] * scale * __expf(cu[e]); kh[e] = k[e] * __expf(ct[e] - cu[e]); }
                    const size_t go = (((size_t)chain_ * 128 + c) * 64 + row) * 128 + d0;
                    v4u o2; o2.x = pk2(qh[0], qh[1]); o2.y = pk2(qh[2], qh[3]); o2.z = pk2(qh[4], qh[5]); o2.w = pk2(qh[6], qh[7]); *(v4u*)(QH + go) = o2;
                    o2.x = pk2(kh[0], kh[1]); o2.y = pk2(kh[2], kh[3]); o2.z = pk2(kh[4], kh[5]); o2.w = pk2(kh[6], kh[7]); *(v4u*)(KH + go) = o2; }
                v4u o; o.x = pk2(qt[0], qt[1]); o.y = pk2(qt[2], qt[3]); o.z = pk2(qt[4], qt[5]); o.w = pk2(qt[6], qt[7]); *(LAS v4u*)(Qt + row * LQ + d0) = o;
                o.x = pk2(kt[0], kt[1]); o.y = pk2(kt[2], kt[3]); o.z = pk2(kt[4], kt[5]); o.w = pk2(kt[6], kt[7]); *(LAS v4u*)(Kt + row * LQ + d0) = o; }
            __syncthreads();
#pragma unroll
            for (int q = 0; q < 2; ++q) { const int ti = 2 * w + q, tr = ti >> 2, tc = ti & 3;
                if (tc <= tr) { const f32x4 acc = mm16<4>(Qt + 16 * tr * LQ, LQ, Kt + 16 * tc * LQ, LQ, (f32x4){0.f, 0.f, 0.f, 0.f}, lane); const int s = 16 * tc + (lane & 15);
#pragma unroll
                    for (int j = 0; j < 4; ++j) { const int t = 16 * tr + (lane >> 4) * 4 + j; Ps[t * LT + s] = f2bf((s <= t) ? acc[j] : 0.f); }
                } else {
#pragma unroll
                    for (int j = 0; j < 4; ++j) Ps[(16 * tr + (lane >> 4) * 4 + j) * LT + 16 * tc + (lane & 15)] = 0;
                } }
            __syncthreads();
            { const int row = tid >> 3, cc = tid & 7; const int chain = (b * 4 + h) * 2 + dir; *(v4u*)(PPG + (((size_t)chain * 128 + c) * 64 + row) * 64 + 8 * cc) = *(const LAS v4u*)(Ps + row * LT + 8 * cc); }
        }
    }
}
DI void gla_phase(const Ctx& C, const bf16* PROJ, const float* CUM, const bf16* PPG, const bf16* QH, const bf16* KH, bf16* OF, bf16* OB) {
    constexpr int LQ = 136, LT = 72;
    LAS bf16* Qt = (LAS bf16*)(C.lds); LAS bf16* Qh = (LAS bf16*)(C.lds + 17408); LAS bf16* Kt = (LAS bf16*)(C.lds + 34816); LAS bf16* KT = (LAS bf16*)(C.lds + 52224);
    LAS bf16* VT = (LAS bf16*)(C.lds + 70656); LAS bf16* Ps = (LAS bf16*)(C.lds + 75264); LAS bf16* ST = (LAS bf16*)(C.lds + 84480); LAS float* etot = (LAS float*)(C.lds + 93184);
    const int tid = C.tid, lane = C.lane, w = C.wave;
    const float scale = 0.08838834764831845f;
    if (DBG_SKIP & 16) { for (int i = blockIdx.x * NTHR + tid; i < T * 1024; i += gridDim.x * NTHR) { const int tok = i >> 10, ch = i & 1023; OF[i] = f2bf(CUM[(size_t)tok * 512 + (ch & 511)]); OB[i] = f2bf(CUM[((size_t)T + tok) * 512 + (ch & 511)]); } return; }
    for (int item = blockIdx.x; item < 128; item += gridDim.x) {
        const int chain = (item & 7) * 2 + (item >> 6), eb = (item >> 3) & 7, dir = chain & 1, h = (chain >> 1) & 3, b = chain >> 3;
        bf16* OO = dir ? OB : OF;
        f32x4 Sacc[2];
        Sacc[0] = (f32x4){0.f, 0.f, 0.f, 0.f}; Sacc[1] = Sacc[0];
        for (int i = tid; i < 32 * LQ / 2; i += NTHR) ((LAS unsigned*)ST)[i] = 0u;
        v4u pq[2], tk[2], pp; v2u tv; float tet = 0.f;
#define GLA_LOAD(c) do { const size_t cc_ = (size_t)chain * 128 + (c); \
            pp = *(const v4u*)(PPG + (cc_ * 64 + (tid >> 3)) * 64 + 8 * (tid & 7)); \
            _Pragma("unroll") for (int i = 0; i < 2; ++i) { const int idx = tid + NTHR * i; pq[i] = *(const v4u*)(QH + cc_ * 8192 + (size_t)idx * 8); } \
            { const bf16* kp = KH + (cc_ * 64 + lane) * 128 + 16 * w; tk[0] = *(const v4u*)kp; tk[1] = *(const v4u*)(kp + 8); \
              tv = *(const v2u*)(PROJ + TOKOF((c), lane) * CD_N + 1024 + h * 256 + eb * 32 + 4 * w); } \
            if (tid < 128) tet = CUM[((size_t)dir * T + TOKOF((c), 63)) * 512 + h * 128 + tid]; } while (0)
        GLA_LOAD(0);
        __syncthreads();
        for (int c = 0; c < SEQ / 64; ++c) {
#pragma unroll
            for (int i = 0; i < 2; ++i) { const int idx = tid + NTHR * i, row = idx >> 4, cc = idx & 15; *(LAS v4u*)(Qh + row * LQ + 8 * cc) = pq[i]; }
            *(LAS v4u*)(Ps + (tid >> 3) * LT + 8 * (tid & 7)) = pp;
            if (tid < 128) etot[tid] = __expf(tet);
            { const v4u k0 = tk[0], k1 = tk[1]; const v2u v = tv; LAS bf16* kt = KT + (16 * w) * LT + lane;
                kt[0 * LT] = (bf16)(k0.x & 0xffffu); kt[1 * LT] = (bf16)(k0.x >> 16); kt[2 * LT] = (bf16)(k0.y & 0xffffu); kt[3 * LT] = (bf16)(k0.y >> 16);
                kt[4 * LT] = (bf16)(k0.z & 0xffffu); kt[5 * LT] = (bf16)(k0.z >> 16); kt[6 * LT] = (bf16)(k0.w & 0xffffu); kt[7 * LT] = (bf16)(k0.w >> 16);
                kt[8 * LT] = (bf16)(k1.x & 0xffffu); kt[9 * LT] = (bf16)(k1.x >> 16); kt[10 * LT] = (bf16)(k1.y & 0xffffu); kt[11 * LT] = (bf16)(k1.y >> 16);
                kt[12 * LT] = (bf16)(k1.z & 0xffffu); kt[13 * LT] = (bf16)(k1.z >> 16); kt[14 * LT] = (bf16)(k1.w & 0xffffu); kt[15 * LT] = (bf16)(k1.w >> 16);
                LAS bf16* vt = VT + (4 * w) * LT + lane;
                vt[0 * LT] = (bf16)(v.x & 0xffffu); vt[1 * LT] = (bf16)(v.x >> 16); vt[2 * LT] = (bf16)(v.y & 0xffffu); vt[3 * LT] = (bf16)(v.y >> 16); }
            if (c + 1 < SEQ / 64) GLA_LOAD(c + 1);
            LBAR();
            { const int tr = w >> 1, tc = w & 1;
                f32x4 acc = mm16<4>(Qh + 16 * tr * LQ, LQ, ST + 16 * tc * LQ, LQ, (f32x4){0.f, 0.f, 0.f, 0.f}, lane);
                acc = mm16<2>(Ps + 16 * tr * LT, LT, VT + 16 * tc * LT, LT, acc, lane);
#pragma unroll
                for (int j = 0; j < 4; ++j) { const int t = 16 * tr + (lane >> 4) * 4 + j; OO[TOKOF(c, t) * 1024 + h * 256 + eb * 32 + 16 * tc + (lane & 15)] = f2bf(acc[j]); } }
#pragma unroll
            for (int ct = 0; ct < 2; ++ct) {
#pragma unroll
                for (int j = 0; j < 4; ++j) Sacc[ct][j] *= etot[16 * w + (lane >> 4) * 4 + j];
                Sacc[ct] = mm16<2>(KT + 16 * w * LT, LT, VT + 16 * ct * LT, LT, Sacc[ct], lane); }
            LBAR();
#pragma unroll
            for (int ct = 0; ct < 2; ++ct) { if (DBG_SKIP & 32) break; v2u o; o.x = pk2(Sacc[ct][0], Sacc[ct][1]); o.y = pk2(Sacc[ct][2], Sacc[ct][3]); *(LAS v2u*)(ST + (16 * ct + (lane & 15)) * LQ + 16 * w + (lane >> 4) * 4) = o; }
        }
#undef GLA_LOAD
        __syncthreads();
    }
}

constexpr int SSEG = 128, SNSEG = SEQ / SSEG;
struct S5P { const float *a_re, *a_im, *log_dt, *b_re, *b_im, *c_re, *c_im, *d; };
DI void s5_disc(const S5P& P, int dir, int g, int p, float& lr, float& li, f32x2 (&bb)[16]) {
    const float dt = expf(P.log_dt[dir * 64 + g]); const float are = P.a_re[(dir * 64 + g) * 64 + p], aim = P.a_im[(dir * 64 + g) * 64 + p];
    const float mag = expf(dt * are); lr = mag * cosf(dt * aim); li = mag * sinf(dt * aim);
    const float den = are * are + aim * aim, nr = lr - 1.0f; const float cr = (nr * are + li * aim) / den, ci = (li * are - nr * aim) / den;
    const f32x4* br = (const f32x4*)(P.b_re + (size_t)(g * 64 + p) * 16); const f32x4* bi = (const f32x4*)(P.b_im + (size_t)(g * 64 + p) * 16);
#pragma unroll
    for (int q = 0; q < 4; ++q) { const f32x4 r = br[q], i = bi[q];
#pragma unroll
        for (int e = 0; e < 4; ++e) bb[4 * q + e] = (f32x2){cr * r[e] - ci * i[e], cr * i[e] + ci * r[e]}; }
}
DI f32x2 s5_step(const LAS f32x4* up, const f32x2 (&bb)[16], float lr, float li, f32x2 x) {
    const f32x4 u0 = up[0], u1 = up[1], u2 = up[2], u3 = up[3];
    f32x2 a = bb[0] * u0.x; a += bb[1] * u0.y; a += bb[2] * u0.z; a += bb[3] * u0.w; a += bb[4] * u1.x; a += bb[5] * u1.y; a += bb[6] * u1.z; a += bb[7] * u1.w;
    f32x2 c = bb[8] * u2.x; c += bb[9] * u2.y; c += bb[10] * u2.z; c += bb[11] * u2.w; c += bb[12] * u3.x; c += bb[13] * u3.y; c += bb[14] * u3.z; c += bb[15] * u3.w;
    const f32x2 xs = {x.y, x.x};
    return x * lr + (xs * (f32x2){-li, li} + (a + c));
}
DI void s5_stage_u(const bf16* U  , size_t tok0, LAS bf16* UW, int lane) {
#pragma unroll
    for (int i = 0; i < 4; ++i) { const int q = lane + 64 * i, tl = q >> 1, hf = q & 1; *(LAS v4u*)(UW + tl * 16 + hf * 8) = *(const v4u*)(U + (tok0 + tl) * CD_N + hf * 8); }
    asm volatile("s_waitcnt vmcnt(0) lgkmcnt(0)" ::: "memory");
}
DI void s5_load_u(const LAS bf16* UW, int tl, float (&u)[16]) {
    const v4u a = *(const LAS v4u*)(UW + tl * 16), b = *(const LAS v4u*)(UW + tl * 16 + 8);
    u[0] = bflo(a.x); u[1] = bfhi(a.x); u[2] = bflo(a.y); u[3] = bfhi(a.y); u[4] = bflo(a.z); u[5] = bfhi(a.z); u[6] = bflo(a.w); u[7] = bfhi(a.w);
    u[8] = bflo(b.x); u[9] = bfhi(b.x); u[10] = bflo(b.y); u[11] = bfhi(b.y); u[12] = bflo(b.z); u[13] = bfhi(b.z); u[14] = bflo(b.w); u[15] = bfhi(b.w);
}
DI void s5_passA(const Ctx& C, const S5P& P, const bf16* PROJ, f32x2* END) {
    LAS float* UF = (LAS float*)(C.lds + C.wave * 8192);
    for (int item = C.gw; item < BATCH * SNSEG * 64 * 2; item += C.ngw) {
        const int dir = item & 1, g = (item >> 1) & 63, seg = (item >> 7) & (SNSEG - 1), b = item >> 13; const int lane = C.lane; const size_t tok0 = (size_t)b * SEQ + seg * SSEG;
        float lr, li; f32x2 bb[16]; s5_disc(P, dir, g, lane, lr, li, bb);
#pragma unroll
        for (int i = 0; i < 4; ++i) { const int q = lane + 64 * i, tl = q >> 1, hf = q & 1; const v4u v = *(const v4u*)(PROJ + (tok0 + tl) * CD_N + 3072 + g * 16 + hf * 8);
            *(LAS f32x4*)(UF + tl * 16 + hf * 8) = (f32x4){bflo(v.x), bfhi(v.x), bflo(v.y), bfhi(v.y)}; *(LAS f32x4*)(UF + tl * 16 + hf * 8 + 4) = (f32x4){bflo(v.z), bfhi(v.z), bflo(v.w), bfhi(v.w)}; }
        f32x2 x = {0.f, 0.f};
#pragma unroll 2
        for (int i = 0; i < SSEG; ++i) { const int tl = dir ? SSEG - 1 - i : i; x = s5_step((const LAS f32x4*)(UF + tl * 16), bb, lr, li, x); }
        const int sl = dir ? SNSEG - 1 - seg : seg;
        END[((size_t)((b * 2 + dir) * SNSEG + sl)) * 4096 + g * 64 + lane] = x;
        asm volatile("s_waitcnt lgkmcnt(0)" ::: "memory");
    }
}
DI void s5_gen_G(const Ctx& C, const S5P& P, bf16* G) {
    for (int item = blockIdx.x; item < 128; item += gridDim.x) { const int dir = item & 1, g = item >> 1, p = C.lane;
        float lr, li; f32x2 bb[16]; s5_disc(P, dir, g, p, lr, li, bb);
        const int j0 = 16 * C.wave; int e0 = dir ? j0 : 127 - (j0 + 15);
        float pr = 1.f, pi = 0.f; { float br = lr, bi = li; int n = e0;
#pragma unroll
            for (int it = 0; it < 7; ++it) { if (n & 1) { const float t = pr * br - pi * bi; pi = pr * bi + pi * br; pr = t; } const float t2 = br * br - bi * bi; bi = 2.f * br * bi; br = t2; n >>= 1; } }
        bf16* gre = G + ((size_t)item * 128 + p) * 2048; bf16* gim = gre + (size_t)64 * 2048;
#pragma unroll 1
        for (int s = 0; s < 16; ++s) { const int j = dir ? j0 + s : j0 + 15 - s;
            float re[16], im[16];
#pragma unroll
            for (int c = 0; c < 16; ++c) { re[c] = pr * bb[c].x - pi * bb[c].y; im[c] = pr * bb[c].y + pi * bb[c].x; }
            v4u o; o.x = pk2(re[0], re[1]); o.y = pk2(re[2], re[3]); o.z = pk2(re[4], re[5]); o.w = pk2(re[6], re[7]); *(v4u*)(gre + j * 16) = o;
            o.x = pk2(re[8], re[9]); o.y = pk2(re[10], re[11]); o.z = pk2(re[12], re[13]); o.w = pk2(re[14], re[15]); *(v4u*)(gre + j * 16 + 8) = o;
            o.x = pk2(im[0], im[1]); o.y = pk2(im[2], im[3]); o.z = pk2(im[4], im[5]); o.w = pk2(im[6], im[7]); *(v4u*)(gim + j * 16) = o;
            o.x = pk2(im[8], im[9]); o.y = pk2(im[10], im[11]); o.z = pk2(im[12], im[13]); o.w = pk2(im[14], im[15]); *(v4u*)(gim + j * 16 + 8) = o;
            const float t = pr * lr - pi * li; pi = pr * li + pi * lr; pr = t; }
    }
}
DI void s5_end_gemm(const Ctx& C, const bf16* PROJ, const bf16* G, float* ENDF) {
    const int lane = C.lane, fr = lane & 15, fq = lane >> 4, w = C.wave;
    for (int item = blockIdx.x; item < 256; item += gridDim.x) { const int nh = item & 1, gd = item >> 1, dir = gd & 1, g = gd >> 1;
        const int ar = 16 * w + fr, ab = ar >> 6, as = ar & 63;
        const bf16* ap = PROJ + ((size_t)g * T + ab * SEQ + as * SSEG) * 16 + 8 * fq;
        const bf16* bp = G + ((size_t)gd * 128 + nh * 64 + fr) * 2048 + 8 * fq;
        f32x4 acc[4];
#pragma unroll
        for (int ct = 0; ct < 4; ++ct) acc[ct] = (f32x4){0.f, 0.f, 0.f, 0.f};
#pragma unroll 4
        for (int ks = 0; ks < 64; ++ks) { const bf16x8 a = *(const bf16x8*)(ap + 32 * ks);
#pragma unroll
            for (int ct = 0; ct < 4; ++ct) acc[ct] = mfma16(a, *(const bf16x8*)(bp + (size_t)ct * 16 * 2048 + 32 * ks), acc[ct]); }
#pragma unroll
        for (int ct = 0; ct < 4; ++ct)
#pragma unroll
            for (int j = 0; j < 4; ++j) { const int r = 16 * w + fq * 4 + j, b = r >> 6, s = r & 63, sl = dir ? SNSEG - 1 - s : s;
                ENDF[((size_t)((b * 2 + dir) * SNSEG + sl)) * 8192 + g * 128 + nh * 64 + ct * 16 + fr] = acc[ct][j]; }
    }
}
DI void s5_passB(const Ctx& C, const S5P& P, const f32x2* END, f32x2* CARR) {
    const int gt = blockIdx.x * NTHR + C.tid;
    if (gt < BATCH * 2 * 4096) { const int p = gt & 63, g = (gt >> 6) & 63, bd = gt >> 12, dir = bd & 1;
        const float dt = expf(P.log_dt[dir * 64 + g]); const float are = P.a_re[(dir * 64 + g) * 64 + p], aim = P.a_im[(dir * 64 + g) * 64 + p];
        const float mag = expf(dt * are); float lr = mag * cosf(dt * aim), li = mag * sinf(dt * aim);
#pragma unroll
        for (int i = 0; i < 7; ++i) { const float nr = lr * lr - li * li, ni = 2.0f * lr * li; lr = nr; li = ni; }
        float cr = 0.f, ci = 0.f;
        for (int sl = 0; sl < SNSEG; ++sl) { const size_t idx = ((size_t)(bd * SNSEG + sl)) * 4096 + (gt & 4095); CARR[idx] = (f32x2){cr, ci}; const f32x2 e = END[idx];
            const float nr = lr * cr - li * ci + e.x, ni = lr * ci + li * cr + e.y; cr = nr; ci = ni; }
    }
}
DI float s5_reduce16(float (&v)[16], int lane) {
    float a[8];
#pragma unroll
    for (int i = 0; i < 8; ++i) { const bool hi = (lane & 32) != 0; const float keep = hi ? v[i + 8] : v[i], send = hi ? v[i] : v[i + 8]; a[i] = keep + __shfl_xor(send, 32); }
    float b[4];
#pragma unroll
    for (int i = 0; i < 4; ++i) { const bool hi = (lane & 16) != 0; const float keep = hi ? a[i + 4] : a[i], send = hi ? a[i] : a[i + 4]; b[i] = keep + __shfl_xor(send, 16); }
    float c[2];
#pragma unroll
    for (int i = 0; i < 2; ++i) { const bool hi = (lane & 8) != 0; const float keep = hi ? b[i + 2] : b[i], send = hi ? b[i] : b[i + 2]; c[i] = keep + __shfl_xor(send, 8); }
    const bool hi = (lane & 4) != 0; const float keep = hi ? c[1] : c[0], send = hi ? c[0] : c[1]; float d = keep + __shfl_xor(send, 4);
    d += __shfl_xor(d, 1); d += __shfl_xor(d, 2);
    return d;
}
template <int DIRN, int SUB> DI void s5_subtile(const LAS float* UF, LAS bf16* XT, float lr, float li, const f32x2 (&bb)[16], f32x2& x,
                                                const bf16x8 (&bfr)[4], f32x4& acc0, f32x4& acc1, int lane) {
#pragma unroll 1
    for (int i = 0; i < 32; ++i) { const int r = DIRN ? 31 - i : i;
        x = s5_step((const LAS f32x4*)(UF + (32 * SUB + r) * 16), bb, lr, li, x);
        const unsigned pkd = pk2(x.x, x.y); XT[r * 136 + lane] = (bf16)(pkd & 0xffffu); XT[r * 136 + 64 + lane] = (bf16)(pkd >> 16); }
#pragma unroll
    for (int ks = 0; ks < 4; ++ks) { const bf16x8 a0 = *(const LAS bf16x8*)(XT + (lane & 15) * 136 + 32 * ks + 8 * (lane >> 4)), a1 = *(const LAS bf16x8*)(XT + (16 + (lane & 15)) * 136 + 32 * ks + 8 * (lane >> 4));
        acc0 = mfma16(a0, bfr[ks], acc0); acc1 = mfma16(a1, bfr[ks], acc1); }
}
template <int DIRN> DI void s5_dir(const S5P& P, const f32x2* END, const LAS float* UF, LAS bf16* XT, int b, int seg, int g, const bf16x8 (&bfr)[4], f32x4 (&acc)[8], int lane) {
    float lr, li; f32x2 bb[16]; s5_disc(P, DIRN, g, lane, lr, li, bb);
    const int sl = DIRN ? SNSEG - 1 - seg : seg; float xr = 0.f, xi = 0.f;
    { float Lr = lr, Li = li;
#pragma unroll
        for (int i = 0; i < 7; ++i) { const float nr = Lr * Lr - Li * Li, ni = 2.0f * Lr * Li; Lr = nr; Li = ni; }
#pragma unroll 8
        for (int j = 0; j < sl; ++j) { const float* ep = (const float*)END + ((size_t)((b * 2 + DIRN) * SNSEG + j)) * 8192 + g * 128 + lane; const f32x2 e = {ep[0], ep[64]}; const float nr = Lr * xr - Li * xi + e.x, ni = Lr * xi + Li * xr + e.y; xr = nr; xi = ni; } }
    f32x2 x = {xr, xi};
    if (DIRN == 0) { s5_subtile<0, 0>(UF, XT, lr, li, bb, x, bfr, acc[0], acc[1], lane); s5_subtile<0, 1>(UF, XT, lr, li, bb, x, bfr, acc[2], acc[3], lane);
                     s5_subtile<0, 2>(UF, XT, lr, li, bb, x, bfr, acc[4], acc[5], lane); s5_subtile<0, 3>(UF, XT, lr, li, bb, x, bfr, acc[6], acc[7], lane); }
    else {           s5_subtile<1, 3>(UF, XT, lr, li, bb, x, bfr, acc[6], acc[7], lane); s5_subtile<1, 2>(UF, XT, lr, li, bb, x, bfr, acc[4], acc[5], lane);
                     s5_subtile<1, 1>(UF, XT, lr, li, bb, x, bfr, acc[2], acc[3], lane); s5_subtile<1, 0>(UF, XT, lr, li, bb, x, bfr, acc[0], acc[1], lane); }
}
DI void s5_passC(const Ctx& C, const S5P& P, const bf16* PROJ, const f32x2* END, bf16* YG  , int item_lo, int item_hi) {
    LAS float* UF = (LAS float*)(C.lds + C.wave * 16896); LAS bf16* XT = (LAS bf16*)(C.lds + C.wave * 16896 + 8192);
    for (int item = item_lo + C.gw; item < item_hi; item += C.ngw) {
        int lane = C.lane; asm volatile("" : "+v"(lane));
        const int g = item & 63, seg = (item >> 6) & (SNSEG - 1), b = item >> 12; const size_t tok0 = (size_t)b * SEQ + seg * SSEG;
#pragma unroll
        for (int i = 0; i < 4; ++i) { const int q = lane + 64 * i, tl = q >> 1, hf = q & 1; const v4u v = *(const v4u*)(PROJ + ((size_t)g * T + tok0 + tl) * 16 + hf * 8);
            *(LAS f32x4*)(UF + tl * 16 + hf * 8) = (f32x4){bflo(v.x), bfhi(v.x), bflo(v.y), bfhi(v.y)}; *(LAS f32x4*)(UF + tl * 16 + hf * 8 + 4) = (f32x4){bflo(v.z), bfhi(v.z), bflo(v.w), bfhi(v.w)}; }
        bf16x8 bfr[4];
#pragma unroll
        for (int ks = 0; ks < 4; ++ks) { const float* src = (ks < 2 ? P.c_re : P.c_im) + (size_t)(g * 16 + (lane & 15)) * 64 + 32 * (ks & 1) + 8 * (lane >> 4); const f32x4 a = *(const f32x4*)src, bq = *(const f32x4*)(src + 4);
            const float sg = ks < 2 ? 1.0f : -1.0f; v4u w; w.x = pk2(sg * a.x, sg * a.y); w.y = pk2(sg * a.z, sg * a.w); w.z = pk2(sg * bq.x, sg * bq.y); w.w = pk2(sg * bq.z, sg * bq.w); bfr[ks] = __builtin_bit_cast(bf16x8, w); }
        f32x4 acc[8];
#pragma unroll
        for (int r = 0; r < 8; ++r) acc[r] = (f32x4){0.f, 0.f, 0.f, 0.f};
        s5_dir<0>(P, END, UF, XT, b, seg, g, bfr, acc, lane);
        s5_dir<1>(P, END, UF, XT, b, seg, g, bfr, acc, lane);
        const float dv = P.d[g * 16 + (lane & 15)];
#pragma unroll
        for (int r = 0; r < 8; ++r)
#pragma unroll
            for (int j = 0; j < 4; ++j) { const int t = 16 * r + (lane >> 4) * 4 + j; const float y = acc[r][j] + dv * UF[t * 16 + (lane & 15)]; YG[(tok0 + t) * 1024 + g * 16 + (lane & 15)] = f2bf(gelu_tanh(y)); }
        asm volatile("s_waitcnt lgkmcnt(0)" ::: "memory");
    }
}
DI void zero_half(const Ctx& C, bf16* Y  ) { for (int it = C.gw; it < T; it += C.ngw) { v4u z = {0u, 0u, 0u, 0u}; *(v4u*)(Y + (size_t)it * D + 16 * C.lane) = z; *(v4u*)(Y + (size_t)it * D + 16 * C.lane + 8) = z; } }
struct Args { const float* in[32]; float* out; unsigned char* ws; int ph_lo, ph_hi; };
constexpr int N_PHASES = 3 + 5 + 2 + 3 + 5 + 2 + 1;

__global__ void __launch_bounds__(NTHR, 2) hybrid_fwd(Args args) {
    extern __shared__ __attribute__((aligned(16))) unsigned char lds_raw[];
    cg::grid_group grid = cg::this_grid();
    LAS unsigned char* const lds0 = (LAS unsigned char*)lds_raw;
    volatile LAS unsigned* xst = (volatile LAS unsigned*)(lds0 + LDS_BYTES - 16);
    if (threadIdx.x == 0) { xst[0] = 0u; xst[1] = 0u; }
    unsigned* barw = (unsigned*)args.ws;
    __syncthreads();
    XcdBarrier xbar = xcd_barrier_post(barw, xst);
    if (args.ph_lo < 0) grid.sync();
    const int lo = args.ph_lo, hi = args.ph_hi; int ph = 0;
#define X outl
#define GATES ((float*)(wsl + WS_GATES))
#define AGG ((f32x2*)(wsl + WS_AGG))
#define WGT ((bf16*)(wsl + WS_WGT))
#define W_MIN ((bf16*)(wsl + WS_MIN))
#define W_MOUT ((bf16*)(wsl + WS_MOUT))
#define W_GLU ((bf16*)(wsl + WS_GLU))
#define W_LRU ((bf16*)(wsl + WS_LRUW))
#define HN ((bf16*)(wsl + WS_HN))
#define YMIX ((bf16*)(wsl + WS_YMIX))
#define BIG ((bf16*)(wsl + WS_BIG))
#define HF ((bf16*)(wsl + WS_HF))
#define HB ((bf16*)(wsl + WS_HB))
#define GP (wsl + WS_GP)
#define W_GU ((bf16*)(wsl + WS_GU) + (size_t)f * (2 * FF) * D)
#define W_DN ((bf16*)(wsl + WS_DN) + (size_t)f * D * FF)
#define ROWSS ((pg8::rowss_t*)(wsl + WS_CAR))
#define ROWSS_ (ROWSS + (size_t)(l == 0 ? 0 : 3) * T)
#define LA ((bf16*)GP)
#define BV ((bf16*)(GP + 64 * MiB))
#define CUM ((float*)GP)
#define SEND ((f32x2*)(GP + 64 * MiB))
#define YG ((bf16*)(GP + 80 * MiB))
#define MKP const S5P P{args.in[21], args.in[22], args.in[23], args.in[24], args.in[25], args.in[26], args.in[27], args.in[28]}
#define PH_BEGIN if (ph >= lo && ph < hi) { Ctx C; { int t_ = threadIdx.x; asm volatile("" : "+v"(t_)); C.lds = lds0; C.tid = t_; C.lane = t_ & 63; C.wave = __builtin_amdgcn_readfirstlane(t_ >> 6); C.gw = blockIdx.x * NWAVES + C.wave; C.ngw = gridDim.x * NWAVES; } unsigned char* wsl = args.ws; float* outl = args.out; asm volatile("" : "+s"(wsl), "+s"(outl));
#define PH_END } if (ph >= lo && ph + 1 < hi) xcd_barrier(xbar); ++ph;
    for (int st = 0; st < 6; ++st) {
        const int l = st / 3, k = st % 3;
        if (k == 1 && (DBG_SKIP & (1 << l))) { ph += 5; continue; }
        if (k != 1) {
            const int f = k >> 1;
            if (st == 0 || st == 3) {
            PH_BEGIN
                REP(1) {
                if (st == 0) { for (int i = blockIdx.x * NTHR + C.tid; i < 6 * T; i += gridDim.x * NTHR) ROWSS[i] = 0ull; }
                if (k == 0) {
                    if (l == 0) { conv_gu(C, args.in[2], (bf16*)(wsl + WS_GU)); conv_gu(C, args.in[6], (bf16*)(wsl + WS_GU) + (size_t)(2 * FF) * D);
                        conv_plain(C, args.in[3], D, FF, D, 1 << 30, 0, (bf16*)(wsl + WS_DN)); conv_plain(C, args.in[7], D, FF, D, 1 << 30, 0, (bf16*)(wsl + WS_DN) + (size_t)D * FF);
                        conv_plain(C, args.in[8], AB_LD, D, AB_N, 1 << 30, 0, W_MIN); conv_plain(C, args.in[16], D, D, D, 1 << 30, 0, W_MOUT); conv_small(C, args.in[8], AB_LD, AB_N, 16, WGT);
                        for (int m = 0; m < 32; ++m) conv_plain(C, args.in[11] + (size_t)m * 128 * 128, 128, 128, 128, 1 << 30, 0, W_LRU + (size_t)m * 128 * 128); }
                    else { conv_gu(C, args.in[6] + (size_t)D * 2 * FF, (bf16*)(wsl + WS_GU) + (size_t)(2 * FF) * D); conv_plain(C, args.in[7] + (size_t)FF * D, D, FF, D, 1 << 30, 0, (bf16*)(wsl + WS_DN) + (size_t)D * FF);
                        conv_plain(C, args.in[30], D, D, D, 1 << 30, 0, W_MOUT); }
                }
                if (st == 0) rms_rows_bf16(C, args.in[0], args.in[1], HN); }
            PH_END
            }
            PH_BEGIN REP(2) { pg8::Gemm g{HN, W_GU, T, 2 * FF, D}; pg8::StaticOrder S; S.init(T, 2 * FF, gridDim.x, blockIdx.x); pg8::EpiSwiglu E{BIG, FF, st == 0 ? nullptr : ROWSS + (size_t)(st == 2 ? 1 : st == 3 ? 2 : 4) * T};
                pg8::gemm_phase<pg8::EpiSwiglu, pg8::StaticOrder, true, true>(C.lds, g, S, E); }
            PH_END
            PH_BEGIN { pg8::Gemm g{BIG, W_DN, T, D, FF}; pg8::StaticOrder S; S.init(T, D, gridDim.x, blockIdx.x); pg8::EpiResid E{st == 0 ? args.in[0] : X, X, D, 0.5f, st == 5 ? nullptr : HN, st == 0 ? args.in[4] : st == 2 ? args.in[1] + D : args.in[4] + D, ROWSS + (size_t)(st == 0 ? 0 : st == 2 ? 2 : 3) * T};
                pg8::gemm_phase<pg8::EpiResid, pg8::StaticOrder, false, true>(C.lds, g, S, E); }
            PH_END
        } else if (l == 0) {
            PH_BEGIN REP(256) { gate_gemm<1>(C, HN, WGT, args.in[14], GATES, ROWSS_); asm volatile("s_waitcnt vmcnt(0)" ::: "memory"); __syncthreads();
                pg8::Gemm g{HN, W_MIN, T, AB_N, D}; pg8::StaticOrder S; S.init(T, AB_N, gridDim.x, blockIdx.x); pg8::EpiStoreBf16 E{BIG, AB_N, ROWSS_, nullptr, 0};
                pg8::gemm_phase<pg8::EpiStoreBf16, pg8::StaticOrder, true, true>(C.lds, g, S, E); }
            PH_END
            PH_BEGIN REP(1024) mlstm_pre(C, BIG, GATES, (f32x4*)HN, HN + 2 * MiB); PH_END
            PH_BEGIN
                REP(8192) {
                if (blockIdx.x < 128) mlstm_phase<false>(C, BIG, (const f32x4*)HN, HN + 2 * MiB, HF, HB, xbar);
                else { Ctx C2 = C; C2.gw = (blockIdx.x - 128) * NWAVES + C.wave; C2.ngw = (gridDim.x - 128) * NWAVES;
                    REP(16384) lru_gate_phase(C2, BIG, args.in[9], args.in[10], W_LRU, args.in[12], args.in[13], LA, BV); half_barrier(barw + 16, gridDim.x - 128);
                    REP(32768) lru_pass1(C2, LA, BV, AGG); half_barrier(barw + 80, gridDim.x - 128);
                    REP(65536) lru_pass3(C2, LA, BV, AGG, BIG, nullptr, YMIX);
                    __syncthreads();
                    conv_gu(C2, args.in[2] + (size_t)D * 2 * FF, (bf16*)(wsl + WS_GU)); conv_plain(C2, args.in[3] + (size_t)FF * D, D, FF, D, 1 << 30, 0, (bf16*)(wsl + WS_DN));
                    conv_plain(C2, args.in[17], CD_LD, D, CD_N, 3072, 32, W_MIN); conv_small(C2, args.in[17], CD_LD, 3072, 32, WGT); conv_plain(C2, args.in[29], 1024, 1024, 1024, 1 << 30, 0, W_GLU); } }
            PH_END
            PH_BEGIN REP(128) hnorm_phase<0>(C, HF, HB, args.in[15], BIG + 5120, AB_N, YMIX + 1024); PH_END
            PH_BEGIN { pg8::Gemm g{YMIX, W_MOUT, T, D, D}; pg8::StaticOrder S; S.init(T, D, gridDim.x, blockIdx.x); pg8::EpiResid E{X, X, D, 1.0f, HN, args.in[5], ROWSS_ + (size_t)1 * T};
                pg8::gemm_phase<pg8::EpiResid, pg8::StaticOrder, false, true>(C.lds, g, S, E); }
            PH_END
        } else {
            PH_BEGIN REP(256) { { MKP; s5_gen_G(C, P, HF); }
                gate_gemm<2>(C, HN, WGT, nullptr, GATES, ROWSS_); asm volatile("s_waitcnt vmcnt(0)" ::: "memory"); __syncthreads();
                pg8::Gemm g{HN, W_MIN, T, CD_N, D}; pg8::StaticOrder S; S.init(T, CD_N, gridDim.x, blockIdx.x); pg8::EpiStoreBf16 E{BIG, CD_N, ROWSS_, YMIX, 3072};
                pg8::gemm_phase<pg8::EpiStoreBf16, pg8::StaticOrder, true, true>(C.lds, g, S, E); }
            PH_END
            PH_BEGIN MKP; REP(64) { gla_cum_phase(C, GATES, args.in[18], args.in[19], CUM, BIG, HN, BIG + 64 * MiB, BIG + 80 * MiB); __syncthreads(); } REP(32) s5_end_gemm(C, YMIX, HF, (float*)SEND); PH_END
            PH_BEGIN
                MKP;
                REP(4096) {
                constexpr int S5_SPLIT = 6144;
                if (blockIdx.x < 128) { gla_phase(C, BIG, CUM, HN, BIG + 64 * MiB, BIG + 80 * MiB, HF, HB); __syncthreads();
                    Ctx C2 = C; C2.ngw = 128 * NWAVES; s5_passC(C2, P, YMIX, SEND, YG, S5_SPLIT, BATCH * SNSEG * 64); }
                else { Ctx C2 = C; C2.gw = (blockIdx.x - 128) * NWAVES + C.wave; C2.ngw = (gridDim.x - 128) * NWAVES; s5_passC(C2, P, YMIX, SEND, YG, 0, S5_SPLIT); } }
            PH_END
            PH_BEGIN REP(2048) { hnorm_phase<1>(C, HF, HB, args.in[20], BIG + 2048, CD_N, YMIX); asm volatile("s_waitcnt vmcnt(0)" ::: "memory"); __syncthreads();
                pg8::Gemm g{YG, W_GLU, T, 1024, 1024}; pg8::StaticOrder S; S.init(T, 1024, gridDim.x, blockIdx.x); pg8::EpiGlu E{YG, 1024, YMIX + 1024, D};
                pg8::gemm_phase<pg8::EpiGlu, pg8::StaticOrder, true, true>(C.lds, g, S, E); }
            PH_END
            PH_BEGIN { pg8::Gemm g{YMIX, W_MOUT, T, D, D}; pg8::StaticOrder S; S.init(T, D, gridDim.x, blockIdx.x); pg8::EpiResid E{X, X, D, 1.0f, HN, args.in[5] + D, ROWSS_ + (size_t)1 * T};
                pg8::gemm_phase<pg8::EpiResid, pg8::StaticOrder, false, true>(C.lds, g, S, E); }
            PH_END
        }
    }
    for (int xs_ = 0; xs_ < DBG_XSYNC; ++xs_) xcd_barrier(xbar);
    PH_BEGIN REP(512) rms_rows_f32(C, X, args.in[31]); PH_END
#undef PH_BEGIN
#undef PH_END
}
#undef X
#undef GATES
#undef AGG
#undef WGT
#undef W_MIN
#undef W_MOUT
#undef W_GLU
#undef W_LRU
#undef HN
#undef YMIX
#undef BIG
#undef HF
#undef HB
#undef GP
#undef W_GU
#undef W_DN
#undef ROWSS
#undef ROWSS_
#undef LA
#undef BV
#undef CUM
#undef SEND
#undef YG
#undef MKP

#ifndef MULTI_LAUNCH
#define MULTI_LAUNCH 0
#endif
extern "C" void kernel_launch(void* const* d_in, const int* in_sizes, int n_in, void* d_out, int out_size, void* d_ws, size_t ws_size, hipStream_t stream) {
    static int grid = 0;
    if (grid == 0) {
        if (n_in != 32 || out_size != T * D || ws_size < WS_END) { fprintf(stderr, "kernel_launch: unexpected shapes (n_in %d out %d ws %zu)\n", n_in, out_size, ws_size); grid = -1; return; }
        int dev = 0, cus = 0, per_cu = 0;
        (void)hipGetDevice(&dev); (void)hipDeviceGetAttribute(&cus, hipDeviceAttributeMultiprocessorCount, dev);
        if (hipFuncSetAttribute((const void*)hybrid_fwd, hipFuncAttributeMaxDynamicSharedMemorySize, LDS_BYTES) != hipSuccess) { fprintf(stderr, "kernel_launch: hipFuncSetAttribute failed\n"); grid = -1; return; }
        if (hipOccupancyMaxActiveBlocksPerMultiprocessor(&per_cu, (const void*)hybrid_fwd, NTHR, LDS_BYTES) != hipSuccess || per_cu < 1) { fprintf(stderr, "kernel_launch: occupancy query gave %d\n", per_cu); per_cu = 1; }
        (void)hipGetLastError();
        grid = cus * 1;
    }
    if (grid < 0) return;
    Args a{};
    for (int i = 0; i < 32; ++i) a.in[i] = (const float*)d_in[i];
    a.out = (float*)d_out; a.ws = (unsigned char*)d_ws;
#if MULTI_LAUNCH
    for (int p = 0; p < N_PHASES; ++p) { a.ph_lo = p; a.ph_hi = p + 1; hipLaunchKernelGGL(hybrid_fwd, dim3(grid), dim3(NTHR), LDS_BYTES, stream, a); }
#else
    a.ph_lo = 0; a.ph_hi = N_PHASES;
    if (hipMemsetAsync(d_ws, 0, 16384, stream) != hipSuccess) { fprintf(stderr, "kernel_launch: hipMemsetAsync of the barrier words failed\n"); return; }
    void* kargs[] = {&a};
    const hipError_t e = hipLaunchCooperativeKernel((const void*)hybrid_fwd, dim3(grid), dim3(NTHR), kargs, LDS_BYTES, stream);
    if (e != hipSuccess) fprintf(stderr, "kernel_launch: cooperative launch failed: %s (grid %d)\n", hipGetErrorString(e), grid);
#endif
}
```

```cpp
#define DBG_SKIP 0
#define DBG_DUP 0
#define DBG_XSYNC 0
#include <hip/hip_runtime.h>
#include <hip/hip_cooperative_groups.h>
#include <cstdio>
#include <cstdint>
namespace cg = cooperative_groups;
namespace pg8 {
#define PG8_LAS __attribute__((address_space(3)))
typedef unsigned short bf16_t;
typedef short bf16x8 __attribute__((ext_vector_type(8)));
typedef float f32x4 __attribute__((ext_vector_type(4)));
typedef unsigned u32x4 __attribute__((ext_vector_type(4)));
constexpr int BM = 256, BK = 64, HALF = 128, HTB = HALF * BK * 2  , STAGE_BYTES = 8 * HTB, NXCD = 8, WGM = 4;

__host__ __device__ __forceinline__ int lds_byte(int r, int c) { const int st = (r >> 4) * 2 + (c >> 5), rr = r & 15, cc = c & 31, ob = rr * 64 + cc * 2; return st * 1024 + (ob ^ (((ob >> 9) & 1) << 5)); }
__host__ __device__ __forceinline__ void stage_rc(int b, int& R, int& C) { const int st = b / 1024, sb = b % 1024, swz = sb ^ (((sb >> 9) & 1) << 5); R = (st >> 1) * 16 + swz / 64; C = (st & 1) * 32 + (swz % 64) / 2; }
__host__ __device__ __forceinline__ int perm32(int rho) { const int n = rho >> 4, i = rho & 15; return 8 * (i >> 2) + 4 * n + (i & 3); }

struct Unit { int pm, pn; };
struct Gemm { const bf16_t* A; const bf16_t* Bt; int M, N, K; };

struct StaticOrder {
    int nM, nN, nwg, G, c;
    __host__ __device__ void init(int M, int N, int G_, int c_) { nM = M / BM; nN = N / BM; nwg = nM * nN; G = G_; c = c_; }
    __host__ __device__ bool next(int i, Unit& u) const {
        const long L = (long)i * G + c; if (L >= nwg) return false;
        int wgid = (int)L; { const int q = nwg / NXCD, r = nwg % NXCD, xcd = wgid % NXCD, off = wgid / NXCD; wgid = (xcd < r ? xcd * (q + 1) : r * (q + 1) + (xcd - r) * q) + off; }
        const int nig = WGM * nN, gid = wgid / nig, fm = gid * WGM, gsz = (nM - fm) < WGM ? (nM - fm) : WGM;
        u.pm = fm + ((wgid % nig) % gsz); u.pn = (wgid % nig) / gsz; return true;
    }
    __device__ __forceinline__ void a_ready(const Unit&) const {}
    __device__ __forceinline__ void done(const Unit&) const {}
};

typedef __bf16 bf16x2_t __attribute__((ext_vector_type(2)));
__device__ __forceinline__ unsigned cvt_pk_bf16(float lo, float hi) { bf16x2_t v = {(__bf16)lo, (__bf16)hi}; return __builtin_bit_cast(unsigned, v); }
typedef float f32x2 __attribute__((ext_vector_type(2)));
__device__ __forceinline__ float ep_sigmoid(float x) { return __builtin_amdgcn_rcpf(1.0f + __expf(-x)); }
typedef unsigned long long rowss_t;
__device__ __forceinline__ float ep_rstd(const rowss_t* rowss, int row) { return __builtin_amdgcn_rsqf((float)rowss[row] * (1.0f / 16777216.0f) * (1.0f / 2048.0f) + 1e-6f); }
struct EpiStoreBf16 {
    static constexpr bool PERM = true, AFTER_DRAIN = false;
    bf16_t* O; int ldc; const rowss_t* rowss; bf16_t* O2; int c2_lo;
    __device__ __forceinline__ void operator()(const f32x4 (&acc)[2][2][4][2], const Unit& u, int wr, int wc, int fr, int fq) const {
        const int row0 = u.pm * BM + wr * 64 + fr; const int col0 = u.pn * BM + wc * 32 + 8 * fq;
#pragma unroll
        for (int ai = 0; ai < 2; ++ai)
#pragma unroll
            for (int m = 0; m < 4; ++m) { bf16_t* rowp = O + (size_t)(row0 + ai * HALF + m * 16) * ldc + col0;
                const float rs = rowss ? ep_rstd(rowss, row0 + ai * HALF + m * 16) : 1.0f;
#pragma unroll
                for (int bj = 0; bj < 2; ++bj) { const f32x4 v0 = acc[ai][bj][m][0] * rs, v1 = acc[ai][bj][m][1] * rs;
                    u32x4 w; w.x = cvt_pk_bf16(v0[0], v0[1]); w.y = cvt_pk_bf16(v0[2], v0[3]); w.z = cvt_pk_bf16(v1[0], v1[1]); w.w = cvt_pk_bf16(v1[2], v1[3]);
                    *(u32x4*)(rowp + bj * HALF) = w;
                    if (O2 && col0 + bj * HALF >= c2_lo) { const int cc = col0 + bj * HALF - c2_lo; *(u32x4*)(O2 + ((size_t)(cc >> 4) * 16384 + (row0 + ai * HALF + m * 16)) * 16 + (cc & 15)) = w; } } }
    }
};
struct EpiSwiglu {
    static constexpr bool PERM = true, AFTER_DRAIN = false;
    bf16_t* O; int ldo; const rowss_t* rowss;
    __device__ __forceinline__ void operator()(const f32x4 (&acc)[2][2][4][2], const Unit& u, int wr, int wc, int fr, int fq) const {
        const int row0 = u.pm * BM + wr * 64 + fr; const int col0 = u.pn * HALF + wc * 32 + 8 * fq;
#pragma unroll
        for (int ai = 0; ai < 2; ++ai)
#pragma unroll
            for (int m = 0; m < 4; ++m) { bf16_t* rowp = O + (size_t)(row0 + ai * HALF + m * 16) * ldo + col0;
                float o[8]; const float rs = rowss ? ep_rstd(rowss, row0 + ai * HALF + m * 16) : 1.0f;
#pragma unroll
                for (int n = 0; n < 2; ++n)
#pragma unroll
                    for (int j = 0; j < 4; ++j) { const float g = acc[ai][0][m][n][j] * rs, uu = acc[ai][1][m][n][j] * rs; o[4 * n + j] = g * ep_sigmoid(g) * uu; }
                u32x4 w; w.x = cvt_pk_bf16(o[0], o[1]); w.y = cvt_pk_bf16(o[2], o[3]); w.z = cvt_pk_bf16(o[4], o[5]); w.w = cvt_pk_bf16(o[6], o[7]);
                *(u32x4*)rowp = w; }
    }
};
struct EpiResid {
    static constexpr bool PERM = false, AFTER_DRAIN = false;
    const float* base; float* out; int ldc; float scale; bf16_t* xg; const float* gn; rowss_t* rowss;
    __device__ __forceinline__ void operator()(const f32x4 (&acc)[2][2][4][2], const Unit& u, int wr, int wc, int fr, int fq) const {
        const int row0 = u.pm * BM + wr * 64 + fr; const int col0 = u.pn * BM + wc * 32 + 4 * fq;
        f32x4 gv[2][2];
#pragma unroll
        for (int bj = 0; bj < 2; ++bj)
#pragma unroll
            for (int n = 0; n < 2; ++n) gv[bj][n] = xg ? *(const f32x4*)(gn + col0 + bj * HALF + n * 16) : (f32x4){0.f, 0.f, 0.f, 0.f};
#pragma unroll
        for (int ai = 0; ai < 2; ++ai)
#pragma unroll
            for (int m = 0; m < 4; ++m) { const size_t off = (size_t)(row0 + ai * HALF + m * 16) * ldc + col0; float ss = 0.f;
#pragma unroll
                for (int bj = 0; bj < 2; ++bj)
#pragma unroll
                    for (int n = 0; n < 2; ++n) { const f32x4 bs = *(const f32x4*)(base + off + bj * HALF + n * 16); const f32x4 o = bs + acc[ai][bj][m][n] * scale;
                        *(f32x4*)(out + off + bj * HALF + n * 16) = o;
                        if (xg) { ss += (o[0] * o[0] + o[1] * o[1]) + (o[2] * o[2] + o[3] * o[3]); const f32x4 og = o * gv[bj][n];
                            typedef unsigned u32x2v __attribute__((ext_vector_type(2))); u32x2v w; w.x = cvt_pk_bf16(og[0], og[1]); w.y = cvt_pk_bf16(og[2], og[3]); *(u32x2v*)(xg + off + bj * HALF + n * 16) = w; } }
                if (xg) { ss += __shfl_xor(ss, 16); ss += __shfl_xor(ss, 32); if (fq == 0) atomicAdd(rowss + row0 + ai * HALF + m * 16, (rowss_t)(ss * 16777216.0f)); } }
    }
};
struct EpiGlu {
    static constexpr bool PERM = true, AFTER_DRAIN = false;
    const bf16_t* Y; int ldy; bf16_t* O; int ldo;
    __device__ __forceinline__ void operator()(const f32x4 (&acc)[2][2][4][2], const Unit& u, int wr, int wc, int fr, int fq) const {
        const int row0 = u.pm * BM + wr * 64 + fr; const int col0 = u.pn * BM + wc * 32 + 8 * fq;
#pragma unroll
        for (int ai = 0; ai < 2; ++ai)
#pragma unroll
            for (int m = 0; m < 4; ++m) { const size_t r = (size_t)(row0 + ai * HALF + m * 16);
#pragma unroll
                for (int bj = 0; bj < 2; ++bj) { const int c = col0 + bj * HALF; const u32x4 yv = *(const u32x4*)(Y + r * ldy + c);
                    const f32x4 v0 = acc[ai][bj][m][0], v1 = acc[ai][bj][m][1];
                    float y[8]; y[0] = __uint_as_float(yv.x << 16); y[1] = __uint_as_float(yv.x & 0xffff0000u); y[2] = __uint_as_float(yv.y << 16); y[3] = __uint_as_float(yv.y & 0xffff0000u);
                    y[4] = __uint_as_float(yv.z << 16); y[5] = __uint_as_float(yv.z & 0xffff0000u); y[6] = __uint_as_float(yv.w << 16); y[7] = __uint_as_float(yv.w & 0xffff0000u);
                    u32x4 w; w.x = cvt_pk_bf16(y[0] * ep_sigmoid(v0[0]), y[1] * ep_sigmoid(v0[1])); w.y = cvt_pk_bf16(y[2] * ep_sigmoid(v0[2]), y[3] * ep_sigmoid(v0[3]));
                    w.z = cvt_pk_bf16(y[4] * ep_sigmoid(v1[0]), y[5] * ep_sigmoid(v1[1])); w.w = cvt_pk_bf16(y[6] * ep_sigmoid(v1[2]), y[7] * ep_sigmoid(v1[3]));
                    *(u32x4*)(O + r * ldo + c) = w; } }
    }
};
template <class Epi, class Sched, bool ALIGN_EPI = false, bool SP2 = false>
__device__ __forceinline__ void gemm_phase(PG8_LAS unsigned char* lds, const Gemm g, const Sched& S, const Epi& E) {
    int tid_ = threadIdx.x; asm volatile("" : "+v"(tid_));
    const int tid = tid_, wid = __builtin_amdgcn_readfirstlane(tid >> 6), lane = tid & 63, wr = wid >> 2, wc = wid & 3, fr = lane & 15, fq = lane >> 4;
    const int K = g.K, nt = K / BK;
    unsigned voffA[2], voffB[2];
#pragma unroll
    for (int i = 0; i < 2; ++i) { int R, C; stage_rc(tid * 16 + i * 8192, R, C); const int Rb = Epi::PERM ? ((R & ~31) + perm32(R & 31)) : R;
        voffA[i] = (unsigned)(R * K + C) * 2u; voffB[i] = (unsigned)(Rb * K + C) * 2u; }
    const size_t kstep = (size_t)(BK * 2);
    const size_t hstep = (size_t)HALF * K * 2;
    const size_t tstep = 2 * hstep;
    const unsigned ldsw = (unsigned)wid * 1024u;
    const int aoff = lds_byte(wr * 64 + fr, fq * 8), boff = lds_byte(wc * 32 + fr, fq * 8);
#define PG8_SA(b, h) (((b) * 2 + (h)) * HTB)
#define PG8_SB(b, h) ((4 + (b) * 2 + (h)) * HTB)
#define PG8_STAGE(bufoff, gbase, voff) do { _Pragma("unroll") for (int _i = 0; _i < 2; ++_i) \
        __builtin_amdgcn_global_load_lds((const unsigned*)((const char*)(gbase) + (voff)[_i]), (PG8_LAS unsigned*)(lds + (bufoff) + ldsw + _i * 8192), 16, 0, 0); } while (0)
#define PG8_LDA(dst, b, h) do { _Pragma("unroll") for (int m = 0; m < 4; ++m) _Pragma("unroll") for (int k = 0; k < 2; ++k) dst[m][k] = *(const PG8_LAS bf16x8*)(lds + PG8_SA(b, h) + aoff + m * 2048 + k * 1024); } while (0)
#define PG8_LDB(dst, b, h) do { _Pragma("unroll") for (int n = 0; n < 2; ++n) _Pragma("unroll") for (int k = 0; k < 2; ++k) dst[n][k] = *(const PG8_LAS bf16x8*)(lds + PG8_SB(b, h) + boff + n * 2048 + k * 1024); } while (0)
#define PG8_MMA(ai, bj, At, Bt) do { __builtin_amdgcn_s_setprio(1); _Pragma("unroll") for (int m = 0; m < 4; ++m) _Pragma("unroll") for (int n = 0; n < 2; ++n) _Pragma("unroll") for (int k = 0; k < 2; ++k) \
        acc[ai][bj][m][n] = __builtin_amdgcn_mfma_f32_16x16x32_bf16(Bt[n][k], At[m][k], acc[ai][bj][m][n], 0, 0, 0); __builtin_amdgcn_s_setprio(0); } while (0)
#define PG8_WAIT_V(n) asm volatile("s_waitcnt vmcnt(" #n ")" ::: "memory")
#define PG8_WAIT_L(n) asm volatile("s_waitcnt lgkmcnt(" #n ")" ::: "memory")
#define PG8_BAR __builtin_amdgcn_s_barrier()
#define PG8_SCHED __builtin_amdgcn_sched_barrier(0)
    Unit cur, nxt; int ui = 0;
    if (!S.next(0, cur)) return;
    f32x4 acc[2][2][4][2];
#pragma unroll
    for (int a = 0; a < 2; ++a)
#pragma unroll
        for (int b = 0; b < 2; ++b)
#pragma unroll
            for (int m = 0; m < 4; ++m)
#pragma unroll
                for (int n = 0; n < 2; ++n) acc[a][b][m][n] = (f32x4){0.f, 0.f, 0.f, 0.f};
    bf16x8 At[4][2], B0[2][2], B1[2][2];
    const char* cA = (const char*)g.A + (size_t)cur.pm * tstep; const char* cB = (const char*)g.Bt + (size_t)cur.pn * tstep;
    S.a_ready(cur);
    if constexpr (SP2) {
        PG8_STAGE(PG8_SB(0, 0), cB, voffB); PG8_STAGE(PG8_SB(0, 1), cB + hstep, voffB); PG8_STAGE(PG8_SA(0, 0), cA, voffA); PG8_STAGE(PG8_SA(0, 1), cA + hstep, voffA);
        if (wr == 1) PG8_BAR;
        PG8_WAIT_V(2); PG8_BAR;
        PG8_STAGE(PG8_SB(1, 0), cB + kstep, voffB); PG8_STAGE(PG8_SA(1, 0), cA + kstep, voffA); PG8_STAGE(PG8_SB(1, 1), cB + hstep + kstep, voffB);
        PG8_WAIT_V(6); PG8_BAR;
    } else {
        PG8_STAGE(PG8_SB(0, 0), cB, voffB); PG8_STAGE(PG8_SA(0, 0), cA, voffA); PG8_STAGE(PG8_SB(0, 1), cB + hstep, voffB); PG8_STAGE(PG8_SA(0, 1), cA + hstep, voffA);
        if (wr == 1) PG8_BAR;
        PG8_WAIT_V(4); PG8_BAR;
        PG8_STAGE(PG8_SB(1, 0), cB + kstep, voffB); PG8_STAGE(PG8_SA(1, 0), cA + kstep, voffA); PG8_STAGE(PG8_SB(1, 1), cB + hstep + kstep, voffB);
        PG8_WAIT_V(6); PG8_BAR;
    }
    for (;;) {
        const bool has_next = S.next(ui + 1, nxt);
        const char* nA = has_next ? (const char*)g.A + (size_t)nxt.pm * tstep : cA; const char* nB = has_next ? (const char*)g.Bt + (size_t)nxt.pn * tstep : cB;
        for (int t = 0; t < nt; t += 2) {
            const bool last = (t == nt - 2);
            const char* a1 = cA + (size_t)(t + 1) * kstep;
            const char* a2 = last ? nA : cA + (size_t)(t + 2) * kstep; const char* b2 = last ? nB : cB + (size_t)(t + 2) * kstep;
            const char* a3 = a2 + kstep; const char* b3 = b2 + kstep;
            if (last && has_next) S.a_ready(nxt);
            if constexpr (SP2) {
            PG8_LDB(B0, 0, 0); PG8_LDB(B1, 0, 1); PG8_SCHED; PG8_LDA(At, 0, 0); PG8_STAGE(PG8_SA(1, 1), a1 + hstep, voffA);
            PG8_WAIT_V(8); PG8_WAIT_L(0); PG8_BAR; PG8_MMA(0, 0, At, B0); PG8_MMA(0, 1, At, B1); PG8_BAR; PG8_SCHED;
            PG8_LDA(At, 0, 1); PG8_STAGE(PG8_SB(0, 0), b2, voffB); PG8_STAGE(PG8_SB(0, 1), b2 + hstep, voffB); PG8_STAGE(PG8_SA(0, 0), a2, voffA);
            PG8_WAIT_V(8); PG8_WAIT_L(0); PG8_BAR; PG8_MMA(1, 0, At, B0); PG8_MMA(1, 1, At, B1); PG8_BAR; PG8_SCHED;
            PG8_LDB(B0, 1, 0); PG8_LDB(B1, 1, 1); PG8_SCHED; PG8_LDA(At, 1, 0); PG8_STAGE(PG8_SA(0, 1), a2 + hstep, voffA);
            PG8_WAIT_V(8); PG8_WAIT_L(0); PG8_BAR; PG8_MMA(0, 0, At, B0); PG8_MMA(0, 1, At, B1); PG8_BAR; PG8_SCHED;
            PG8_LDA(At, 1, 1); PG8_STAGE(PG8_SB(1, 0), b3, voffB); PG8_STAGE(PG8_SB(1, 1), b3 + hstep, voffB); PG8_STAGE(PG8_SA(1, 0), a3, voffA);
            PG8_WAIT_V(8); PG8_WAIT_L(0); PG8_BAR; PG8_MMA(1, 0, At, B0); PG8_MMA(1, 1, At, B1); PG8_BAR; PG8_SCHED;
            } else {
            PG8_LDB(B0, 0, 0); PG8_SCHED; PG8_LDA(At, 0, 0); PG8_STAGE(PG8_SA(1, 1), a1 + hstep, voffA);
            PG8_WAIT_L(8); PG8_BAR; PG8_WAIT_L(0); PG8_MMA(0, 0, At, B0); PG8_BAR; PG8_SCHED;
            PG8_LDB(B1, 0, 1); PG8_STAGE(PG8_SB(0, 0), b2, voffB);
            PG8_BAR; PG8_WAIT_L(0); PG8_MMA(0, 1, At, B1); PG8_BAR;
            PG8_LDA(At, 0, 1); PG8_STAGE(PG8_SA(0, 0), a2, voffA);
            PG8_BAR; PG8_WAIT_L(0); PG8_MMA(1, 0, At, B0); PG8_BAR; PG8_SCHED;
            PG8_STAGE(PG8_SB(0, 1), b2 + hstep, voffB);
            PG8_WAIT_V(6); PG8_BAR; PG8_MMA(1, 1, At, B1); PG8_BAR;
            PG8_LDB(B0, 1, 0); PG8_SCHED; PG8_LDA(At, 1, 0); PG8_STAGE(PG8_SA(0, 1), a2 + hstep, voffA);
            PG8_WAIT_L(8); PG8_BAR; PG8_WAIT_L(0); PG8_MMA(0, 0, At, B0); PG8_BAR; PG8_SCHED;
            PG8_LDB(B1, 1, 1); PG8_STAGE(PG8_SB(1, 0), b3, voffB);
            PG8_BAR; PG8_WAIT_L(0); PG8_MMA(0, 1, At, B1); PG8_BAR;
            PG8_LDA(At, 1, 1); PG8_STAGE(PG8_SA(1, 0), a3, voffA);
            PG8_BAR; PG8_WAIT_L(0); PG8_MMA(1, 0, At, B0); PG8_BAR; PG8_SCHED;
            PG8_STAGE(PG8_SB(1, 1), b3 + hstep, voffB);
            PG8_WAIT_V(6); PG8_BAR; PG8_MMA(1, 1, At, B1); PG8_BAR;
            }
        }
        if constexpr (ALIGN_EPI) { if (wr == 0) PG8_BAR; }
        if constexpr (!Epi::AFTER_DRAIN) { E(acc, cur, wr, wc, fr, fq); S.done(cur); }
        if (!has_next) break;
#pragma unroll
        for (int a = 0; a < 2; ++a)
#pragma unroll
            for (int b = 0; b < 2; ++b)
#pragma unroll
                for (int m = 0; m < 4; ++m)
#pragma unroll
                    for (int n = 0; n < 2; ++n) acc[a][b][m][n] = (f32x4){0.f, 0.f, 0.f, 0.f};
        cur = nxt; cA = nA; cB = nB; ++ui;
        if constexpr (ALIGN_EPI) { if (wr == 1) PG8_BAR; }
    }
    PG8_WAIT_V(0);
    if constexpr (!ALIGN_EPI) { if (wr == 0) PG8_BAR; }
    PG8_BAR;
    if constexpr (Epi::AFTER_DRAIN) { E.fused(acc, cur, wr, wc, fr, fq, lds, wid, lane); S.done(cur); }
#undef PG8_SA
#undef PG8_SB
#undef PG8_STAGE
#undef PG8_LDA
#undef PG8_LDB
#undef PG8_MMA
#undef PG8_WAIT_V
#undef PG8_WAIT_L
#undef PG8_BAR
#undef PG8_SCHED
}
}

#define DI __device__ __forceinline__
#define LAS __attribute__((address_space(3)))
typedef unsigned short bf16;
typedef unsigned v4u __attribute__((ext_vector_type(4)));
typedef unsigned v2u __attribute__((ext_vector_type(2)));
typedef float f32x4 __attribute__((ext_vector_type(4)));
typedef float f32x2 __attribute__((ext_vector_type(2)));
typedef short bf16x8 __attribute__((ext_vector_type(8)));

constexpr int NWAVES = 8, NTHR = 512;
constexpr int BATCH = 2, SEQ = 8192, T = BATCH * SEQ, D = 2048, FF = 5632;
constexpr int AB_N = 6144, AB_LD = 6160, CD_N = 4096, CD_LD = 4128;
constexpr float EPS = 1e-6f;
constexpr size_t MiB = 1u << 20;
constexpr size_t WS_GATES = 1 * MiB, WS_AGG = 3 * MiB, WS_CAR = 5 * MiB, WS_WGT = 6 * MiB;
constexpr size_t WS_GU = 8 * MiB  , WS_DN = 96 * MiB  , WS_MIN = 140 * MiB, WS_MOUT = 164 * MiB, WS_GLU = 172 * MiB, WS_LRUW = 174 * MiB;
constexpr size_t WS_HN = 176 * MiB, WS_YMIX = 240 * MiB, WS_BIG = 304 * MiB, WS_GP = 496 * MiB, WS_HF = 624 * MiB, WS_HB = 656 * MiB, WS_END = 688 * MiB;
constexpr int LDS_BYTES = 147456;

DI float bflo(unsigned w) { return __uint_as_float(w << 16); }
DI float bfhi(unsigned w) { return __uint_as_float(w & 0xffff0000u); }
DI float bf2f(bf16 h) { return __uint_as_float(((unsigned)h) << 16); }
DI unsigned pk2(float lo, float hi) { return pg8::cvt_pk_bf16(lo, hi); }
DI bf16 f2bf(float f) { return (bf16)(pk2(f, 0.f) & 0xffffu); }
DI float sigm(float x) { return __builtin_amdgcn_rcpf(1.0f + __expf(-x)); }
DI float softplus_(float x) { return fmaxf(x, 0.f) + log1pf(__expf(-fabsf(x))); }
DI float logsigmoid_(float x) { return fminf(x, 0.f) - __logf(1.0f + __expf(-fabsf(x))); }
DI float gelu_tanh(float x) { const float u = 0.7978845608028654f * (x + 0.044715f * x * x * x); return x * sigm(2.0f * u); }
DI float wave_sum(float v) {
#pragma unroll
    for (int o = 1; o < 64; o <<= 1) v += __shfl_xor(v, o);
    return v;
}
DI f32x4 mfma16(bf16x8 a, bf16x8 b, f32x4 c) { return __builtin_amdgcn_mfma_f32_16x16x32_bf16(a, b, c, 0, 0, 0); }
template <int KT> DI f32x4 mm16(const LAS bf16* A, int lda, const LAS bf16* B, int ldb, f32x4 acc, int lane) {
    const LAS bf16* a = A + (lane & 15) * lda + (lane >> 4) * 8;
    const LAS bf16* b = B + (lane & 15) * ldb + (lane >> 4) * 8;
#pragma unroll
    for (int k = 0; k < KT; ++k) acc = mfma16(*(const LAS bf16x8*)(a + 32 * k), *(const LAS bf16x8*)(b + 32 * k), acc);
    return acc;
}

#ifndef DBG_SKIP
#define DBG_SKIP 0
#endif
#ifndef DBG_DUP
#define DBG_DUP 0
#endif
#ifndef DBG_XSYNC
#define DBG_XSYNC 0
#endif
#define REP(bit) for (int rep_ = 0; rep_ < ((DBG_DUP & (bit)) ? 2 : 1); ++rep_, __syncthreads())
template <int KT> DI f32x4 mm16_ones(const LAS bf16* A, int lda, int lane) {
    const LAS bf16* a = A + (lane & 15) * lda + (lane >> 4) * 8; f32x4 acc = (f32x4){0.f, 0.f, 0.f, 0.f};
    const bf16x8 ones = {0x3F80, 0x3F80, 0x3F80, 0x3F80, 0x3F80, 0x3F80, 0x3F80, 0x3F80};
#pragma unroll
    for (int k = 0; k < KT; ++k) acc = mfma16(*(const LAS bf16x8*)(a + 32 * k), ones, acc);
    return acc;
}
struct Ctx { LAS unsigned char* lds; int tid, lane, wave, gw, ngw; };

#define RLX_AGENT __ATOMIC_RELAXED, __HIP_MEMORY_SCOPE_AGENT
#define XB_TMO      128
#define XB_XCNT(j)  (256  + 64 * (j))
#define XB_XSUB(j)  (1280 + 64 * (j))
#define XB_XGEN(j)  (2304 + 64 * (j))
#define XB_TOP      3328
#define XB_TOPGEN   3392
#define XCD_BAR_WORDS 3456
#define XB_SPIN_CAP (1u << 18)

__device__ __forceinline__ unsigned xb_ld(unsigned* p)              { return __hip_atomic_load(p, __ATOMIC_RELAXED, __HIP_MEMORY_SCOPE_AGENT); }
__device__ __forceinline__ unsigned xb_add(unsigned* p, unsigned v) { return __hip_atomic_fetch_add(p, v, __ATOMIC_RELAXED, __HIP_MEMORY_SCOPE_AGENT); }
__device__ __forceinline__ unsigned xb_xcc_id() { return (unsigned)__builtin_amdgcn_s_getreg((3 << 11) | 20) & 0xFu; }
#define XB_SPIN(cond, bar) do { unsigned _sp = 0; while (cond) { __builtin_amdgcn_s_sleep(1); \
    if ((++_sp & 255u) == 0u) { if (xb_ld(&(bar)[XB_TMO])) break; if (_sp > XB_SPIN_CAP) { atomicAdd(&(bar)[XB_TMO], 1u); break; } } } } while (0)

struct XcdBarrier {
    unsigned* bar; unsigned x;
    volatile LAS unsigned* st;
};

__device__ __forceinline__ XcdBarrier xcd_barrier_post(unsigned* bar, volatile LAS unsigned* st) {
    XcdBarrier b; b.bar = bar; b.x = xb_xcc_id(); b.st = st;
    if (threadIdx.x == 0) (void)xb_add(&bar[XB_XCNT(b.x)], 1u);
    return b;
}
__device__ __forceinline__ void xcd_barrier_complete(unsigned* bar, unsigned x, unsigned& nloc, unsigned& nx) {
    const unsigned G = gridDim.x * gridDim.y * gridDim.z;
    unsigned sum, cnt, mine, sp = 0u;
    for (;;) {
        sum = 0u; cnt = 0u; mine = 0u;
#pragma unroll
        for (unsigned j = 0; j < 16; ++j) { const unsigned c = xb_ld(&bar[XB_XCNT(j)]); sum += c; cnt += (c > 0u) ? 1u : 0u; mine = (j == x) ? c : mine; }
        if (sum == G) break;
        __builtin_amdgcn_s_sleep(1);
        if ((++sp & 255u) == 0u) { if (xb_ld(&bar[XB_TMO])) break; if (sp > XB_SPIN_CAP) { atomicAdd(&bar[XB_TMO], 1u); break; } }
    }
    nloc = mine > 0u ? mine : 1u; nx = cnt > 0u ? cnt : 1u;
}

__device__ __forceinline__ void xcd_barrier(const XcdBarrier& b) {
    asm volatile("s_waitcnt vmcnt(0)" ::: "memory");
    __syncthreads();
    if (threadIdx.x == 0) {
        unsigned* bar = b.bar;
        __builtin_amdgcn_s_waitcnt(0);
        unsigned nloc = b.st[0], nx = b.st[1];
        if (nloc == 0u) { xcd_barrier_complete(bar, b.x, nloc, nx); b.st[0] = nloc; b.st[1] = nx; }
        const unsigned old = xb_add(&bar[XB_XSUB(b.x)], 1u);
        const unsigned gen = old / nloc;
        if (old + 1u == (gen + 1u) * nloc) {
            __builtin_amdgcn_fence(__ATOMIC_RELEASE, "agent");
            asm volatile("s_waitcnt vmcnt(0)" ::: "memory");
            const unsigned og = xb_add(&bar[XB_TOP], 1u);
            const unsigned tg = og / nx;
            if (og + 1u == (tg + 1u) * nx) xb_add(&bar[XB_TOPGEN], 1u);
            else XB_SPIN(xb_ld(&bar[XB_TOPGEN]) == tg, bar);
            __builtin_amdgcn_fence(__ATOMIC_ACQUIRE, "agent");
            xb_add(&bar[XB_XGEN(b.x)], 1u);
            asm volatile("s_waitcnt vmcnt(0)" ::: "memory");
        } else {
            XB_SPIN(xb_ld(&bar[XB_XGEN(b.x)]) == gen, bar);
            __builtin_amdgcn_fence(__ATOMIC_ACQUIRE, "agent");
            asm volatile("s_waitcnt vmcnt(0)" ::: "memory");
        }
    }
    __syncthreads();
}


DI void half_barrier(unsigned* cnt, unsigned n) {
    asm volatile("s_waitcnt vmcnt(0)" ::: "memory"); __syncthreads();
    if (threadIdx.x == 0) {
        __builtin_amdgcn_fence(__ATOMIC_RELEASE, "agent"); asm volatile("s_waitcnt vmcnt(0)" ::: "memory");
        (void)xb_add(cnt, 1u);
        unsigned sp = 0u; while (xb_ld(cnt) < n) { __builtin_amdgcn_s_sleep(1); if (++sp > (1u << 22)) break; }
        __builtin_amdgcn_fence(__ATOMIC_ACQUIRE, "agent"); asm volatile("s_waitcnt vmcnt(0)" ::: "memory");
    }
    __syncthreads();
}
DI void transpose_item(const float* W, int ldw, int k0, int nsrc, bf16* WT, int K, int drow, LAS float* scr, int lane) {
    float tv[32];
#pragma unroll
    for (int i = 0; i < 32; ++i) { const int kk = 2 * i + (lane >> 5); tv[i] = __builtin_nontemporal_load(W + (size_t)(k0 + kk) * ldw + nsrc + (lane & 31)); }
#pragma unroll
    for (int i = 0; i < 32; ++i) { const int kk = 2 * i + (lane >> 5); scr[kk * 33 + (lane & 31)] = tv[i]; }
    asm volatile("s_waitcnt lgkmcnt(0)" ::: "memory");
    const int c = lane & 7;
#pragma unroll
    for (int j = 0; j < 4; ++j) { const int n = (lane >> 3) + 8 * j; const LAS float* s = scr + (8 * c) * 33 + n;
        v4u o; o.x = pk2(s[0 * 33], s[1 * 33]); o.y = pk2(s[2 * 33], s[3 * 33]); o.z = pk2(s[4 * 33], s[5 * 33]); o.w = pk2(s[6 * 33], s[7 * 33]);
        *(v4u*)(WT + (size_t)(drow + n) * K + k0 + 8 * c) = o; }
    asm volatile("s_waitcnt lgkmcnt(0)" ::: "memory");
}
DI void conv_plain(const Ctx& C, const float* W, int ldw, int K, int N, int src_skip_at, int src_skip, bf16* WT) {
    LAS float* scr = (LAS float*)(C.lds + C.wave * 16384);
    const int nb = N / 32, items = (K / 64) * nb;
    for (int it = C.gw; it < items; it += C.ngw) { const int kb = it / nb, n0 = 32 * (it % nb);
        transpose_item(W, ldw, 64 * kb, n0 < src_skip_at ? n0 : n0 + src_skip, WT, K, n0, scr, C.lane); }
}
DI void conv_gu(const Ctx& C, const float* W, bf16* WT) {
    LAS float* scr = (LAS float*)(C.lds + C.wave * 16384);
    constexpr int nb = 2 * FF / 32, items = (D / 64) * nb;
    for (int it = C.gw; it < items; it += C.ngw) { const int kb = it / nb, n0 = 32 * (it % nb);
        const int j = n0 < FF ? n0 : n0 - FF; const int drow = 256 * (j >> 7) + (n0 < FF ? 0 : 128) + (j & 127);
        transpose_item(W, 2 * FF, 64 * kb, n0, WT, D, drow, scr, C.lane); }
}
DI void conv_small(const Ctx& C, const float* W, int ldw, int col0, int nc, bf16* WT) {
    const int gt = C.gw * 64 + C.lane, ngt = C.ngw * 64;
    for (int i = gt; i < nc * D; i += ngt) { const int c = i / D, k = i % D; WT[i] = f2bf(W[(size_t)k * ldw + col0 + c]); }
}

DI void rms_rows_bf16(const Ctx& C, const float* x, const float* g, bf16* out) {
    for (int m = C.gw; m < T; m += C.ngw) {
        const f32x4* xr = (const f32x4*)(x + (size_t)m * D) + C.lane; f32x4 v[8]; float s = 0.f;
#pragma unroll
        for (int j = 0; j < 8; ++j) { v[j] = xr[64 * j]; s += (v[j].x * v[j].x + v[j].y * v[j].y) + (v[j].z * v[j].z + v[j].w * v[j].w); }
        const float rstd = 1.0f / sqrtf(wave_sum(s) * (1.0f / D) + EPS);
        const f32x4* gr = (const f32x4*)g + C.lane; v2u* o = (v2u*)(out + (size_t)m * D) + C.lane;
#pragma unroll
        for (int j = 0; j < 8; ++j) { const f32x4 gv = gr[64 * j]; v2u w; w.x = pk2(v[j].x * rstd * gv.x, v[j].y * rstd * gv.y); w.y = pk2(v[j].z * rstd * gv.z, v[j].w * rstd * gv.w); o[64 * j] = w; }
    }
}
DI void rms_rows_f32(const Ctx& C, float* x, const float* g) {
    for (int m = C.gw; m < T; m += C.ngw) {
        f32x4* xr = (f32x4*)(x + (size_t)m * D) + C.lane; f32x4 v[8]; float s = 0.f;
#pragma unroll
        for (int j = 0; j < 8; ++j) { v[j] = xr[64 * j]; s += (v[j].x * v[j].x + v[j].y * v[j].y) + (v[j].z * v[j].z + v[j].w * v[j].w); }
        const float rstd = 1.0f / sqrtf(wave_sum(s) * (1.0f / D) + EPS);
        const f32x4* gr = (const f32x4*)g + C.lane;
#pragma unroll
        for (int j = 0; j < 8; ++j) { const f32x4 gv = gr[64 * j]; xr[64 * j] = v[j] * rstd * gv; }
    }
}

template <int NT> DI void gate_gemm(const Ctx& C, const bf16* HN, const bf16* WgT, const float* bias, float* G, const pg8::rowss_t* rowss) {
    const int lane = C.lane;
    for (int rt = C.gw; rt < T / 16; rt += C.ngw) {
        f32x4 acc[NT];
#pragma unroll
        for (int n = 0; n < NT; ++n) acc[n] = (f32x4){0.f, 0.f, 0.f, 0.f};
        const bf16* a = HN + (size_t)(rt * 16 + (lane & 15)) * D + (lane >> 4) * 8;
        const bf16* b = WgT + (size_t)(lane & 15) * D + (lane >> 4) * 8;
#pragma unroll 4
        for (int k = 0; k < D / 32; ++k) { const bf16x8 av = *(const bf16x8*)(a + 32 * k);
#pragma unroll
            for (int n = 0; n < NT; ++n) acc[n] = mfma16(av, *(const bf16x8*)(b + (size_t)n * 16 * D + 32 * k), acc[n]); }
#pragma unroll
        for (int n = 0; n < NT; ++n)
#pragma unroll
            for (int j = 0; j < 4; ++j) { const int row = rt * 16 + (lane >> 4) * 4 + j, col = n * 16 + (lane & 15); G[(size_t)row * (16 * NT) + col] = acc[n][j] * pg8::ep_rstd(rowss, row) + (bias ? bias[col] : 0.f); }
    }
}

DI void lru_gate_phase(const Ctx& C, const bf16* PROJ, const float* conv_w, const float* conv_b, const bf16* LW, const float* gate_b, const float* lam, bf16* LA, bf16* BV) {
    LAS bf16* XC = (LAS bf16*)C.lds;
    LAS float* XF = (LAS float*)(C.lds + 17408);
    const int tid = C.tid, lane = C.lane, w = C.wave;
    for (int item = C.gw / NWAVES; item < (T / 64) * 8; item += C.ngw / NWAVES) {
        const int h = item & 7, tok0 = (item >> 3) * 64;
        {
            const int r = tid >> 3, cs = tid & 7, c0 = h * 128 + cs * 16, tok = tok0 + r, ts = tok & (SEQ - 1);
            float a[16];
#pragma unroll
            for (int i = 0; i < 16; ++i) a[i] = conv_b[c0 + i];
#pragma unroll
            for (int k = 0; k < 4; ++k) { const int tk = ts + k - 2;
                if (tk >= 0 && tk < SEQ) { const v4u* p = (const v4u*)(PROJ + (size_t)(tok + k - 2) * AB_N + c0); const v4u x0 = p[0], x1 = p[1]; const float* wk = conv_w + k * 1024 + c0;
                    a[0] += wk[0] * bflo(x0.x); a[1] += wk[1] * bfhi(x0.x); a[2] += wk[2] * bflo(x0.y); a[3] += wk[3] * bfhi(x0.y); a[4] += wk[4] * bflo(x0.z); a[5] += wk[5] * bfhi(x0.z); a[6] += wk[6] * bflo(x0.w); a[7] += wk[7] * bfhi(x0.w);
                    a[8] += wk[8] * bflo(x1.x); a[9] += wk[9] * bfhi(x1.x); a[10] += wk[10] * bflo(x1.y); a[11] += wk[11] * bfhi(x1.y); a[12] += wk[12] * bflo(x1.z); a[13] += wk[13] * bfhi(x1.z); a[14] += wk[14] * bflo(x1.w); a[15] += wk[15] * bfhi(x1.w); } }
            v4u o0, o1; o0.x = pk2(a[0], a[1]); o0.y = pk2(a[2], a[3]); o0.z = pk2(a[4], a[5]); o0.w = pk2(a[6], a[7]); o1.x = pk2(a[8], a[9]); o1.y = pk2(a[10], a[11]); o1.z = pk2(a[12], a[13]); o1.w = pk2(a[14], a[15]);
            *(LAS v4u*)(XC + r * 136 + cs * 16) = o0; *(LAS v4u*)(XC + r * 136 + cs * 16 + 8) = o1;
#pragma unroll
            for (int i = 0; i < 4; ++i) *(LAS f32x4*)(XF + r * 132 + cs * 16 + 4 * i) = (f32x4){a[4 * i], a[4 * i + 1], a[4 * i + 2], a[4 * i + 3]};
        }
        __syncthreads();
        const int j0 = 16 * w, ch = h * 128 + j0 + (lane & 15);
        bf16x8 bfr[4][4];
#pragma unroll
        for (int g = 0; g < 4; ++g)
#pragma unroll
            for (int k = 0; k < 4; ++k) bfr[g][k] = *(const bf16x8*)(LW + ((size_t)(g * 8 + h) * 128 + j0 + (lane & 15)) * 128 + k * 32 + (lane >> 4) * 8);
        float gb[4], sp[2]; bf16* lap = LA + (size_t)tok0 * 1024 + ch; bf16* bvp = BV + (size_t)tok0 * 1024 + ch;
#pragma unroll
        for (int g = 0; g < 4; ++g) gb[g] = gate_b[g * 1024 + ch];
        sp[0] = softplus_(-lam[ch]); sp[1] = softplus_(-lam[1024 + ch]);
#pragma unroll 1
        for (int rt = 0; rt < 4; ++rt) {
            f32x4 acc[4];
#pragma unroll
            for (int g = 0; g < 4; ++g) acc[g] = (f32x4){0.f, 0.f, 0.f, 0.f};
#pragma unroll
            for (int k = 0; k < 4; ++k) { const bf16x8 av = *(const LAS bf16x8*)(XC + (16 * rt + (lane & 15)) * 136 + k * 32 + (lane >> 4) * 8);
#pragma unroll
                for (int g = 0; g < 4; ++g) acc[g] = mfma16(av, bfr[g][k], acc[g]); }
#pragma unroll
            for (int j = 0; j < 4; ++j) { const int t = 16 * rt + (lane >> 4) * 4 + j; const float xv = XF[t * 132 + j0 + (lane & 15)];
#pragma unroll
                for (int dir = 0; dir < 2; ++dir) { const float r = sigm(acc[dir * 2][j] + gb[dir * 2]), ii = sigm(acc[dir * 2 + 1][j] + gb[dir * 2 + 1]);
                    const float la = -8.0f * r * sp[dir]; const float x2 = 2.0f * la;
                    const float om = x2 > -0.3f ? -x2 * (1.0f + x2 * (0.5f + x2 * (0.16666667f + x2 * (0.041666668f + x2 * 0.008333334f)))) : 1.0f - __expf(x2);
                    const float bv = __builtin_amdgcn_sqrtf(om) * ii * xv; const unsigned o = (unsigned)dir * (unsigned)(T * 1024) + (unsigned)t * 1024u;
                    lap[o] = f2bf(la); bvp[o] = f2bf(bv); } }
        }
        __syncthreads();
    }
}
constexpr int LSEG = 128, LNSEG = SEQ / LSEG;
DI void lru_pass1(const Ctx& C, const bf16* LA, const bf16* BV, f32x2* AGG) {
    const int gt = (C.gw / NWAVES) * NTHR + C.tid, ngt = (C.ngw / NWAVES) * NTHR;
    for (int idx = gt; idx < BATCH * 2 * LNSEG * 512; idx += ngt) {
        const int ch = (idx & 511) * 2, sl = (idx >> 9) & (LNSEG - 1), dir = (idx >> 15) & 1, b = idx >> 16;
        float A0 = 1.f, H0 = 0.f, A1 = 1.f, H1 = 0.f;
        const size_t base = ((size_t)dir * T + (size_t)b * SEQ) * 1024 + ch;
#pragma unroll 16
        for (int i = 0; i < LSEG; ++i) { const int li = sl * LSEG + i, t = dir ? SEQ - 1 - li : li; const unsigned o = (unsigned)t * 1024u;
            const unsigned lw = *(const unsigned*)(LA + base + o), bw = *(const unsigned*)(BV + base + o);
            const float a0 = __expf(bflo(lw)), a1 = __expf(bfhi(lw)); A0 *= a0; H0 = a0 * H0 + bflo(bw); A1 *= a1; H1 = a1 * H1 + bfhi(bw); }
        *(f32x4*)(AGG + ((size_t)((b * 2 + dir) * LNSEG + sl)) * 1024 + ch) = (f32x4){A0, H0, A1, H1};
    }
}
DI void lru_pass3(const Ctx& C, const bf16* LA, const bf16* BV, const f32x2* AGG, const bf16* PROJ, float* HT, bf16* YMIX) {
    const int gt = (C.gw / NWAVES) * NTHR + C.tid, ngt = (C.ngw / NWAVES) * NTHR;
    for (int idx = gt; idx < BATCH * LNSEG * 512; idx += ngt) {
        const int ch = (idx & 511) * 2, seg = (idx >> 9) & (LNSEG - 1), b = idx >> 15;
        float h0 = 0.f, h1 = 0.f;
#pragma unroll 8
        for (int s = 0; s < seg; ++s) { const f32x4 e = *(const f32x4*)(AGG + ((size_t)((b * 2 + 0) * LNSEG + s)) * 1024 + ch); h0 = e.x * h0 + e.y; h1 = e.z * h1 + e.w; }
        const size_t tok0 = (size_t)b * SEQ + seg * LSEG; const bf16* la0 = LA + tok0 * 1024 + ch; const bf16* bv0 = BV + tok0 * 1024 + ch; bf16* yp = YMIX + tok0 * D + ch;
#pragma unroll 16
        for (int i = 0; i < LSEG; ++i) { const unsigned lw = *(const unsigned*)(la0 + i * 1024), bw = *(const unsigned*)(bv0 + i * 1024);
            h0 = __expf(bflo(lw)) * h0 + bflo(bw); h1 = __expf(bfhi(lw)) * h1 + bfhi(bw); *(unsigned*)(yp + i * D) = pk2(h0, h1); }
        h0 = 0.f; h1 = 0.f;
#pragma unroll 8
        for (int s = 0; s < LNSEG - 1 - seg; ++s) { const f32x4 e = *(const f32x4*)(AGG + ((size_t)((b * 2 + 1) * LNSEG + s)) * 1024 + ch); h0 = e.x * h0 + e.y; h1 = e.z * h1 + e.w; }
        const bf16* la1 = la0 + (size_t)T * 1024; const bf16* bv1 = bv0 + (size_t)T * 1024; const bf16* gp = PROJ + tok0 * AB_N + 1024 + ch;
#pragma unroll 16
        for (int i = LSEG - 1; i >= 0; --i) { const unsigned lw = *(const unsigned*)(la1 + i * 1024), bw = *(const unsigned*)(bv1 + i * 1024), gw = *(const unsigned*)(gp + (size_t)i * AB_N), fw = *(const unsigned*)(yp + i * D);
            h0 = __expf(bflo(lw)) * h0 + bflo(bw); h1 = __expf(bfhi(lw)) * h1 + bfhi(bw);
            *(unsigned*)(yp + i * D) = pk2(gelu_tanh(bflo(gw)) * (bflo(fw) + h0), gelu_tanh(bfhi(gw)) * (bfhi(fw) + h1)); }
    }
}

template <int ACT  > DI void hnorm_phase(const Ctx& C, const bf16* HF, const bf16* HB, const float* g, const bf16* gate, int ldg, bf16* Y  ) {
    for (int it = C.gw; it < T * 4; it += C.ngw) { const int tok = it >> 2, h = it & 3; const size_t o = (size_t)tok * 1024 + h * 256 + 4 * C.lane;
        const v2u a = *(const v2u*)(HF + o), b = *(const v2u*)(HB + o);
        float v[4] = {bflo(a.x) + bflo(b.x), bfhi(a.x) + bfhi(b.x), bflo(a.y) + bflo(b.y), bfhi(a.y) + bfhi(b.y)};
        const float rstd = 1.0f / sqrtf(wave_sum((v[0] * v[0] + v[1] * v[1]) + (v[2] * v[2] + v[3] * v[3])) * (1.0f / 256.0f) + EPS);
        const f32x4 gv = *(const f32x4*)(g + h * 256 + 4 * C.lane); const v2u gt = *(const v2u*)(gate + (size_t)tok * ldg + h * 256 + 4 * C.lane);
        float z[4] = {bflo(gt.x), bfhi(gt.x), bflo(gt.y), bfhi(gt.y)}, r[4];
#pragma unroll
        for (int i = 0; i < 4; ++i) { const float s = sigm(z[i]); r[i] = v[i] * rstd * gv[i] * (ACT == 0 ? s : z[i] * s); }
        v2u w; w.x = pk2(r[0], r[1]); w.y = pk2(r[2], r[3]); *(v2u*)(Y + (size_t)tok * D + h * 256 + 4 * C.lane) = w; }
}

#define TOKOF(c, l) ((size_t)b * SEQ + (size_t)(dir ? SEQ - 1 - ((c) * 64 + (l)) : ((c) * 64 + (l))))
DI float wave_incl_add(float v, int lane) {
#pragma unroll
    for (int o = 1; o < 64; o <<= 1) { const float t = __shfl_up(v, o); if (lane >= o) v += t; }
    return v;
}
DI float wave_incl_max(float v, int lane) {
#pragma unroll
    for (int o = 1; o < 64; o <<= 1) { const float t = __shfl_up(v, o); if (lane >= o) v = fmaxf(v, t); }
    return v;
}
#define LBAR() do { asm volatile("s_waitcnt lgkmcnt(0)" ::: "memory"); __builtin_amdgcn_s_barrier(); asm volatile("" ::: "memory"); } while (0)
DI void mlstm_pre(const Ctx& C, const bf16* PROJ, const float* GATES, f32x4* TAB, bf16* PP) {
    constexpr int LQ = 264, LT = 72;
    LAS bf16* Qs = (LAS bf16*)(C.lds); LAS bf16* Ks = (LAS bf16*)(C.lds + 33792); LAS float* sg = (LAS float*)(C.lds + 67584); LAS float* spm = sg + 64; LAS bf16* Ps = (LAS bf16*)(C.lds + 68096);
    const int tid = C.tid, lane = C.lane, w = C.wave; const float scale = 0.0625f;
    for (int item = blockIdx.x; item < 16 * (SEQ / 64); item += gridDim.x) {
        const int c = item & 127, chain = item >> 7, dir = chain & 1, h = (chain >> 1) & 3, b = chain >> 3;
        if (w == 0) { const size_t tok = TOKOF(c, lane); const float ig = GATES[tok * 16 + dir * 8 + h], fg = GATES[tok * 16 + dir * 8 + 4 + h];
            const float cum = wave_incl_add(logsigmoid_(fg), lane); const float g = ig - cum; const float pm = wave_incl_max(g, lane);
            TAB[(size_t)item * 64 + lane] = (f32x4){g, cum, pm, 0.f}; sg[lane] = g; spm[lane] = pm; }
#pragma unroll
        for (int i = 0; i < 4; ++i) { const int idx = tid + NTHR * i, row = idx >> 5, cc = idx & 31; const bf16* p = PROJ + TOKOF(c, row) * AB_N + h * 256 + 8 * cc;
            *(LAS v4u*)(Qs + row * LQ + 8 * cc) = *(const v4u*)(p + 2048); *(LAS v4u*)(Ks + row * LQ + 8 * cc) = *(const v4u*)(p + 3072); }
        __syncthreads();
#pragma unroll
        for (int q = 0; q < 2; ++q) { const int ti = 2 * w + q, tr = ti >> 2, tc = ti & 3;
            if (tc <= tr) { const f32x4 acc = mm16<8>(Qs + 16 * tr * LQ, LQ, Ks + 16 * tc * LQ, LQ, (f32x4){0.f, 0.f, 0.f, 0.f}, lane);
                const int s = 16 * tc + (lane & 15); const float gs = sg[s];
#pragma unroll
                for (int j = 0; j < 4; ++j) { const int t = 16 * tr + (lane >> 4) * 4 + j; Ps[t * LT + s] = f2bf((s <= t) ? acc[j] * scale * __expf(gs - spm[t]) : 0.f); }
            } else {
#pragma unroll
                for (int j = 0; j < 4; ++j) Ps[(16 * tr + (lane >> 4) * 4 + j) * LT + 16 * tc + (lane & 15)] = 0;
            } }
        __syncthreads();
        { const int row = tid >> 3, cc = tid & 7; *(v4u*)(PP + ((size_t)item * 64 + row) * 64 + 8 * cc) = *(const LAS v4u*)(Ps + row * LT + 8 * cc); }
        __syncthreads();
    }
}
template <bool INSYNC> DI void mlstm_phase(const Ctx& C, const bf16* PROJ, const f32x4* TAB, const bf16* PP, bf16* HF, bf16* HB, const XcdBarrier& xbar) {
    constexpr int LQ = 264, LT = 72;
    LAS bf16* Qs = (LAS bf16*)(C.lds); LAS bf16* KT = (LAS bf16*)(C.lds + 33792); LAS bf16* VT = (LAS bf16*)(C.lds + 70656); LAS bf16* Ps = (LAS bf16*)(C.lds + 75264);
    LAS bf16* ST = (LAS bf16*)(C.lds + 84480); LAS bf16* NB = (LAS bf16*)(C.lds + 101376); LAS float* SC = (LAS float*)(C.lds + 101888);
    LAS float* s_wi = SC, *s_ws = SC + 64, *s_enm = SC + 128, *s_cf = SC + 192, *s_misc = SC + 256;
    const int tid = C.tid, lane = C.lane, w = C.wave;
    const float scale = 0.0625f;
    const bf16x8 ones = {0x3F80, 0x3F80, 0x3F80, 0x3F80, 0x3F80, 0x3F80, 0x3F80, 0x3F80};
    for (int item = blockIdx.x; item < 128; item += gridDim.x) {
        const int chain = (item & 7) * 2 + (item >> 6), eb = (item >> 3) & 7, dir = chain & 1, h = (chain >> 1) & 3, b = chain >> 3;
        bf16* HO = dir ? HB : HF;
        f32x4 Sacc[2][2], nacc[2];
#pragma unroll
        for (int i = 0; i < 2; ++i) { nacc[i] = (f32x4){0.f, 0.f, 0.f, 0.f};
#pragma unroll
            for (int j = 0; j < 2; ++j) Sacc[i][j] = (f32x4){0.f, 0.f, 0.f, 0.f}; }
        float m_st = 0.f;
        for (int i = tid; i < 32 * LQ / 2; i += NTHR) ((LAS unsigned*)ST)[i] = 0u;
        if (tid < 128) ((LAS unsigned*)NB)[tid] = 0u;
        v4u qreg[4], ktr[4], preg; v2u vreg; f32x4 tg = (f32x4){0.f, 0.f, 0.f, 0.f};
#define MLSTM_LOAD(c) do { if (w == 0) tg = TAB[((size_t)chain * 128 + (c)) * 64 + lane]; \
            _Pragma("unroll") for (int i = 0; i < 4; ++i) { const int idx = tid + NTHR * i, row = idx >> 5, cc = idx & 31; qreg[i] = *(const v4u*)(PROJ + TOKOF((c), row) * AB_N + 2048 + h * 256 + 8 * cc); } \
            { const bf16* pt = PROJ + TOKOF((c), lane) * AB_N + h * 256; _Pragma("unroll") for (int i = 0; i < 4; ++i) ktr[i] = *(const v4u*)(pt + 3072 + 32 * w + 8 * i); \
              vreg = *(const v2u*)(pt + 4096 + eb * 32 + 4 * w); } \
            preg = *(const v4u*)(PP + (((size_t)chain * 128 + (c)) * 64 + (tid >> 3)) * 64 + 8 * (tid & 7)); } while (0)
        MLSTM_LOAD(0);
        __syncthreads();
        for (int c = 0; c < SEQ / 64; ++c) {
            if (INSYNC && (c == 43 || c == 86)) xcd_barrier(xbar);
            if (w == 0) { const float g = tg.x, cum = tg.y + tg.w, pm = tg.z;
                const float rr = -fmaxf(pm, m_st); const float gmax = __shfl(pm, 63), tot = __shfl(cum, 63); const float mm = fmaxf(m_st, gmax);
                s_wi[lane] = __expf(m_st + rr); s_ws[lane] = __expf(g - mm); s_enm[lane] = __expf(rr - cum); s_cf[lane] = __expf(pm + rr);
                if (lane == 0) { s_misc[0] = __expf(m_st - mm); s_misc[1] = tot + mm; } }
            LBAR();
            const float wc = s_misc[0]; m_st = s_misc[1];
#pragma unroll
            for (int i = 0; i < 4; ++i) { const int idx = tid + NTHR * i, row = idx >> 5, cc = idx & 31; *(LAS v4u*)(Qs + row * LQ + 8 * cc) = qreg[i]; }
            { const float ws = s_ws[lane];
#pragma unroll
                for (int i = 0; i < 4; ++i) { const v4u k = ktr[i]; LAS bf16* kt = KT + (32 * w + 8 * i) * LT + lane;
                    kt[0 * LT] = f2bf(bflo(k.x) * ws); kt[1 * LT] = f2bf(bfhi(k.x) * ws); kt[2 * LT] = f2bf(bflo(k.y) * ws); kt[3 * LT] = f2bf(bfhi(k.y) * ws);
                    kt[4 * LT] = f2bf(bflo(k.z) * ws); kt[5 * LT] = f2bf(bfhi(k.z) * ws); kt[6 * LT] = f2bf(bflo(k.w) * ws); kt[7 * LT] = f2bf(bfhi(k.w) * ws); }
                LAS bf16* vt = VT + (4 * w) * LT + lane; const v2u v = vreg;
                vt[0 * LT] = (bf16)(v.x & 0xffffu); vt[1 * LT] = (bf16)(v.x >> 16); vt[2 * LT] = (bf16)(v.y & 0xffffu); vt[3 * LT] = (bf16)(v.y >> 16); }
            *(LAS v4u*)(Ps + (tid >> 3) * LT + 8 * (tid & 7)) = preg;
            if (c + 1 < SEQ / 64) MLSTM_LOAD(c + 1);
            LBAR();
            const int fr = lane & 15, fq = lane >> 4;
            bf16x8 vf[2][2];
#pragma unroll
            for (int ct = 0; ct < 2; ++ct)
#pragma unroll
                for (int k = 0; k < 2; ++k) vf[ct][k] = *(const LAS bf16x8*)(VT + (16 * ct + fr) * LT + 32 * k + 8 * fq);
            { const int tr = w >> 1, tc = w & 1;
                f32x4 accO = (f32x4){0.f, 0.f, 0.f, 0.f}, accN = accO, accP = accO, rsum = accO;
#pragma unroll
                for (int k = 0; k < 8; ++k) { const bf16x8 a = *(const LAS bf16x8*)(Qs + (16 * tr + fr) * LQ + 32 * k + 8 * fq);
                    accO = mfma16(a, *(const LAS bf16x8*)(ST + (16 * tc + fr) * LQ + 32 * k + 8 * fq), accO);
                    accN = mfma16(a, *(const LAS bf16x8*)(NB + 32 * k + 8 * fq), accN);
                    if ((k & 1) == 1) __builtin_amdgcn_sched_barrier(0); }
#pragma unroll
                for (int k = 0; k < 2; ++k) { const bf16x8 p = *(const LAS bf16x8*)(Ps + (16 * tr + fr) * LT + 32 * k + 8 * fq);
                    accP = tc ? mfma16(p, vf[1][k], accP) : mfma16(p, vf[0][k], accP); rsum = mfma16(p, ones, rsum); }
#pragma unroll
                for (int j = 0; j < 4; ++j) { const int t = 16 * tr + fq * 4 + j; const float wi = s_wi[t] * scale, cf = s_cf[t];
                    const float num = accO[j] * wi + accP[j] * cf, den = rsum[j] * cf + wi * accN[j];
                    HO[TOKOF(c, t) * 1024 + h * 256 + eb * 32 + 16 * tc + fr] = f2bf(num * __builtin_amdgcn_rcpf(fmaxf(fabsf(den), s_enm[t]))); } }
#pragma unroll
            for (int i = 0; i < 2; ++i) { bf16x8 kf[2];
#pragma unroll
                for (int k = 0; k < 2; ++k) kf[k] = *(const LAS bf16x8*)(KT + (16 * (2 * w + i) + fr) * LT + 32 * k + 8 * fq);
                nacc[i] = nacc[i] * wc; Sacc[i][0] = Sacc[i][0] * wc; Sacc[i][1] = Sacc[i][1] * wc;
#pragma unroll
                for (int k = 0; k < 2; ++k) { Sacc[i][0] = mfma16(kf[k], vf[0][k], Sacc[i][0]); Sacc[i][1] = mfma16(kf[k], vf[1][k], Sacc[i][1]); nacc[i] = mfma16(kf[k], ones, nacc[i]); } }
            LBAR();
#pragma unroll
            for (int i = 0; i < 2; ++i) {
#pragma unroll
                for (int ct = 0; ct < 2; ++ct) { v2u o; o.x = pk2(Sacc[i][ct][0], Sacc[i][ct][1]); o.y = pk2(Sacc[i][ct][2], Sacc[i][ct][3]);
                    *(LAS v2u*)(ST + (16 * ct + fr) * LQ + 16 * (2 * w + i) + fq * 4) = o; }
                if (fr == 0) { v2u o; o.x = pk2(nacc[i][0], nacc[i][1]); o.y = pk2(nacc[i][2], nacc[i][3]); *(LAS v2u*)(NB + 16 * (2 * w + i) + fq * 4) = o; } }
        }
        __syncthreads();
#undef MLSTM_LOAD
    }
}

DI void gla_cum_phase(const Ctx& C, const float* GLR  , const float* w2  , const float* gb  , float* CUM, const bf16* PROJ, bf16* PPG, bf16* QH, bf16* KH) {
    LAS float* low = (LAS float*)C.lds;
    LAS bf16* Qt = (LAS bf16*)(C.lds + 4096); LAS bf16* Kt = (LAS bf16*)(C.lds + 21504); LAS bf16* Ps = (LAS bf16*)(C.lds + 38912);
    const int tid = C.tid, lane = C.lane, w = C.wave;
    for (int item = blockIdx.x; item < BATCH * (SEQ / 64) * 2; item += gridDim.x) {
        const int dir = item & 1, c = (item >> 1) & 127, b = item >> 8;
        __syncthreads();
        for (int i = tid; i < 1024; i += NTHR) { const int l = i >> 4, r = i & 15; const int li = c * 64 + l; const size_t tok = (size_t)b * SEQ + (dir ? SEQ - 1 - li : li); low[i] = GLR[tok * 32 + dir * 16 + r]; }
        __syncthreads();
        float wr[16];
#pragma unroll
        for (int r = 0; r < 16; ++r) wr[r] = w2[(dir * 16 + r) * 512 + tid];
        const float bias = gb[dir * 512 + tid]; float cum = 0.f;
#pragma unroll 4
        for (int l = 0; l < 64; ++l) { float pre = bias;
#pragma unroll
            for (int r4 = 0; r4 < 4; ++r4) { const f32x4 lv = *(const LAS f32x4*)(low + l * 16 + 4 * r4); pre += lv.x * wr[4 * r4] + lv.y * wr[4 * r4 + 1] + lv.z * wr[4 * r4 + 2] + lv.w * wr[4 * r4 + 3]; }
            cum += logsigmoid_(pre) * 0.0625f; const int li = c * 64 + l; const size_t tok = (size_t)b * SEQ + (dir ? SEQ - 1 - li : li);
            CUM[((size_t)dir * T + tok) * 512 + tid] = cum; }
        __syncthreads();
        constexpr int LQ = 136, LT = 72; const float scale = 0.08838834764831845f;
#pragma unroll 1
        for (int h = 0; h < 4; ++h) {
            const float* cref = CUM + ((size_t)dir * T + TOKOF(c, 31)) * 512 + h * 128;
            const float* ctot = CUM + ((size_t)dir * T + TOKOF(c, 63)) * 512 + h * 128; const int chain_ = (b * 4 + h) * 2 + dir;
#pragma unroll
            for (int i = 0; i < 2; ++i) { const int idx = tid + NTHR * i, row = idx >> 4, cc = idx & 15, d0 = 8 * cc; const size_t tok = TOKOF(c, row);
                const v4u qv = *(const v4u*)(PROJ + tok * CD_N + h * 128 + d0), kv = *(const v4u*)(PROJ + tok * CD_N + 512 + h * 128 + d0);
                const float* cp = CUM + ((size_t)dir * T + tok) * 512 + h * 128 + d0;
                const f32x4 c0 = *(const f32x4*)cp, c1 = *(const f32x4*)(cp + 4), r0 = *(const f32x4*)(cref + d0), r1 = *(const f32x4*)(cref + d0 + 4);
                float q[8] = {bflo(qv.x), bfhi(qv.x), bflo(qv.y), bfhi(qv.y), bflo(qv.z), bfhi(qv.z), bflo(qv.w), bfhi(qv.w)};
                float k[8] = {bflo(kv.x), bfhi(kv.x), bflo(kv.y), bfhi(kv.y), bflo(kv.z), bfhi(kv.z), bflo(kv.w), bfhi(kv.w)};
                float cu[8] = {c0.x, c0.y, c0.z, c0.w, c1.x, c1.y, c1.z, c1.w}, cr[8] = {r0.x, r0.y, r0.z, r0.w, r1.x, r1.y, r1.z, r1.w};
                float qt[8], kt[8];
#pragma unroll
                for (int e = 0; e < 8; ++e) { qt[e] = q[e] * scale * __expf(cu[e] - cr[e]); kt[e] = k[e] * __expf(cr[e] - cu[e]); }
                {
                    const f32x4 t0 = *(const f32x4*)(ctot + d0), t1 = *(const f32x4*)(ctot + d0 + 4); const float ct[8] = {t0.x, t0.y, t0.z, t0.w, t1.x, t1.y, t1.z, t1.w};
                    float qh[8], kh[8];
#pragma unroll
                    for (int e = 0; e < 8; ++e) { qh[e] = q[e] * scale * __expf(cu[e]); kh[e] = k[e] * __expf(ct[e] - cu[e]); }
                    const size_t go = (((size_t)chain_ * 128 + c) * 64 + row) * 128 + d0;
                    v4u o2; o2.x = pk2(qh[0], qh[1]); o2.y = pk2(qh[2], qh[3]); o2.z = pk2(qh[4], qh[5]); o2.w = pk2(qh[6], qh[7]); *(v4u*)(QH + go) = o2;
                    o2.x = pk2(kh[0], kh[1]); o2.y = pk2(kh[2], kh[3]); o2.z = pk2(kh[4], kh[5]); o2.w = pk2(kh[6], kh[7]); *(v4u*)(KH + go) = o2; }
                v4u o; o.x = pk2(qt[0], qt[1]); o.y = pk2(qt[2], qt[3]); o.z = pk2(qt[4], qt[5]); o.w = pk2(qt[6], qt[7]); *(LAS v4u*)(Qt + row * LQ + d0) = o;
                o.x = pk2(kt[0], kt[1]); o.y = pk2(kt[2], kt[3]); o.z = pk2(kt[4], kt[5]); o.w = pk2(kt[6], kt[7]); *(LAS v4u*)(Kt + row * LQ + d0) = o; }
            __syncthreads();
#pragma unroll
            for (int q = 0; q < 2; ++q) { const int ti = 2 * w + q, tr = ti >> 2, tc = ti & 3;
                if (tc <= tr) { const f32x4 acc = mm16<4>(Qt + 16 * tr * LQ, LQ, Kt + 16 * tc * LQ, LQ, (f32x4){0.f, 0.f, 0.f, 0.f}, lane); const int s = 16 * tc + (lane & 15);
#pragma unroll
                    for (int j = 0; j < 4; ++j) { const int t = 16 * tr + (lane >> 4) * 4 + j; Ps[t * LT + s] = f2bf((s <= t) ? acc[j] : 0.f); }
                } else {
#pragma unroll
                    for (int j = 0; j < 4; ++j) Ps[(16 * tr + (lane >> 4) * 4 + j) * LT + 16 * tc + (lane & 15)] = 0;
                } }
            __syncthreads();
            { const int row = tid >> 3, cc = tid & 7; const int chain = (b * 4 + h) * 2 + dir; *(v4u*)(PPG + (((size_t)chain * 128 + c) * 64 + row) * 64 + 8 * cc) = *(const LAS v4u*)(Ps + row * LT + 8 * cc); }
        }
    }
}
DI void gla_phase(const Ctx& C, const bf16* PROJ, const float* CUM, const bf16* PPG, const bf16* QH, const bf16* KH, bf16* OF, bf16* OB) {
    constexpr int LQ = 136, LT = 72;
    LAS bf16* Qt = (LAS bf16*)(C.lds); LAS bf16* Qh = (LAS bf16*)(C.lds + 17408); LAS bf16* Kt = (LAS bf16*)(C.lds + 34816); LAS bf16* KT = (LAS bf16*)(C.lds + 52224);
    LAS bf16* VT = (LAS bf16*)(C.lds + 70656); LAS bf16* Ps = (LAS bf16*)(C.lds + 75264); LAS bf16* ST = (LAS bf16*)(C.lds + 84480); LAS float* etot = (LAS float*)(C.lds + 93184);
    const int tid = C.tid, lane = C.lane, w = C.wave;
    const float scale = 0.08838834764831845f;
    if (DBG_SKIP & 16) { for (int i = blockIdx.x * NTHR + tid; i < T * 1024; i += gridDim.x * NTHR) { const int tok = i >> 10, ch = i & 1023; OF[i] = f2bf(CUM[(size_t)tok * 512 + (ch & 511)]); OB[i] = f2bf(CUM[((size_t)T + tok) * 512 + (ch & 511)]); } return; }
    for (int item = blockIdx.x; item < 128; item += gridDim.x) {
        const int chain = (item & 7) * 2 + (item >> 6), eb = (item >> 3) & 7, dir = chain & 1, h = (chain >> 1) & 3, b = chain >> 3;
        bf16* OO = dir ? OB : OF;
        f32x4 Sacc[2];
        Sacc[0] = (f32x4){0.f, 0.f, 0.f, 0.f}; Sacc[1] = Sacc[0];
        for (int i = tid; i < 32 * LQ / 2; i += NTHR) ((LAS unsigned*)ST)[i] = 0u;
        v4u pq[2], tk[2], pp; v2u tv; float tet = 0.f;
#define GLA_LOAD(c) do { const size_t cc_ = (size_t)chain * 128 + (c); \
            pp = *(const v4u*)(PPG + (cc_ * 64 + (tid >> 3)) * 64 + 8 * (tid & 7)); \
            _Pragma("unroll") for (int i = 0; i < 2; ++i) { const int idx = tid + NTHR * i; pq[i] = *(const v4u*)(QH + cc_ * 8192 + (size_t)idx * 8); } \
            { const bf16* kp = KH + (cc_ * 64 + lane) * 128 + 16 * w; tk[0] = *(const v4u*)kp; tk[1] = *(const v4u*)(kp + 8); \
              tv = *(const v2u*)(PROJ + TOKOF((c), lane) * CD_N + 1024 + h * 256 + eb * 32 + 4 * w); } \
            if (tid < 128) tet = CUM[((size_t)dir * T + TOKOF((c), 63)) * 512 + h * 128 + tid]; } while (0)
        GLA_LOAD(0);
        __syncthreads();
        for (int c = 0; c < SEQ / 64; ++c) {
#pragma unroll
            for (int i = 0; i < 2; ++i) { const int idx = tid + NTHR * i, row = idx >> 4, cc = idx & 15; *(LAS v4u*)(Qh + row * LQ + 8 * cc) = pq[i]; }
            *(LAS v4u*)(Ps + (tid >> 3) * LT + 8 * (tid & 7)) = pp;
            if (tid < 128) etot[tid] = __expf(tet);
            { const v4u k0 = tk[0], k1 = tk[1]; const v2u v = tv; LAS bf16* kt = KT + (16 * w) * LT + lane;
                kt[0 * LT] = (bf16)(k0.x & 0xffffu); kt[1 * LT] = (bf16)(k0.x >> 16); kt[2 * LT] = (bf16)(k0.y & 0xffffu); kt[3 * LT] = (bf16)(k0.y >> 16);
                kt[4 * LT] = (bf16)(k0.z & 0xffffu); kt[5 * LT] = (bf16)(k0.z >> 16); kt[6 * LT] = (bf16)(k0.w & 0xffffu); kt[7 * LT] = (bf16)(k0.w >> 16);
                kt[8 * LT] = (bf16)(k1.x & 0xffffu); kt[9 * LT] = (bf16)(k1.x >> 16); kt[10 * LT] = (bf16)(k1.y & 0xffffu); kt[11 * LT] = (bf16)(k1.y >> 16);
                kt[12 * LT] = (bf16)(k1.z & 0xffffu); kt[13 * LT] = (bf16)(k1.z >> 16); kt[14 * LT] = (bf16)(k1.w & 0xffffu); kt[15 * LT] = (bf16)(k1.w >> 16);
                LAS bf16* vt = VT + (4 * w) * LT + lane;
                vt[0 * LT] = (bf16)(v.x & 0xffffu); vt[1 * LT] = (bf16)(v.x >> 16); vt[2 * LT] = (bf16)(v.y & 0xffffu); vt[3 * LT] = (bf16)(v.y >> 16); }
            if (c + 1 < SEQ / 64) GLA_LOAD(c + 1);
            LBAR();
            { const int tr = w >> 1, tc = w & 1;
                f32x4 acc = mm16<4>(Qh + 16 * tr * LQ, LQ, ST + 16 * tc * LQ, LQ, (f32x4){0.f, 0.f, 0.f, 0.f}, lane);
                acc = mm16<2>(Ps + 16 * tr * LT, LT, VT + 16 * tc * LT, LT, acc, lane);
#pragma unroll
                for (int j = 0; j < 4; ++j) { const int t = 16 * tr + (lane >> 4) * 4 + j; OO[TOKOF(c, t) * 1024 + h * 256 + eb * 32 + 16 * tc + (lane & 15)] = f2bf(acc[j]); } }
#pragma unroll
            for (int ct = 0; ct < 2; ++ct) {
#pragma unroll
                for (int j = 0; j < 4; ++j) Sacc[ct][j] *= etot[16 * w + (lane >> 4) * 4 + j];
                Sacc[ct] = mm16<2>(KT + 16 * w * LT, LT, VT + 16 * ct * LT, LT, Sacc[ct], lane); }
            LBAR();
#pragma unroll
            for (int ct = 0; ct < 2; ++ct) { if (DBG_SKIP & 32) break; v2u o; o.x = pk2(Sacc[ct][0], Sacc[ct][1]); o.y = pk2(Sacc[ct][2], Sacc[ct][3]); *(LAS v2u*)(ST + (16 * ct + (lane & 15)) * LQ + 16 * w + (lane >> 4) * 4) = o; }
        }
#undef GLA_LOAD
        __syncthreads();
    }
}

constexpr int SSEG = 128, SNSEG = SEQ / SSEG;
struct S5P { const float *a_re, *a_im, *log_dt, *b_re, *b_im, *c_re, *c_im, *d; };
DI void s5_disc(const S5P& P, int dir, int g, int p, float& lr, float& li, f32x2 (&bb)[16]) {
    const float dt = expf(P.log_dt[dir * 64 + g]); const float are = P.a_re[(dir * 64 + g) * 64 + p], aim = P.a_im[(dir * 64 + g) * 64 + p];
    const float mag = expf(dt * are); lr = mag * cosf(dt * aim); li = mag * sinf(dt * aim);
    const float den = are * are + aim * aim, nr = lr - 1.0f; const float cr = (nr * are + li * aim) / den, ci = (li * are - nr * aim) / den;
    const f32x4* br = (const f32x4*)(P.b_re + (size_t)(g * 64 + p) * 16); const f32x4* bi = (const f32x4*)(P.b_im + (size_t)(g * 64 + p) * 16);
#pragma unroll
    for (int q = 0; q < 4; ++q) { const f32x4 r = br[q], i = bi[q];
#pragma unroll
        for (int e = 0; e < 4; ++e) bb[4 * q + e] = (f32x2){cr * r[e] - ci * i[e], cr * i[e] + ci * r[e]}; }
}
DI f32x2 s5_step(const LAS f32x4* up, const f32x2 (&bb)[16], float lr, float li, f32x2 x) {
    const f32x4 u0 = up[0], u1 = up[1], u2 = up[2], u3 = up[3];
    f32x2 a = bb[0] * u0.x; a += bb[1] * u0.y; a += bb[2] * u0.z; a += bb[3] * u0.w; a += bb[4] * u1.x; a += bb[5] * u1.y; a += bb[6] * u1.z; a += bb[7] * u1.w;
    f32x2 c = bb[8] * u2.x; c += bb[9] * u2.y; c += bb[10] * u2.z; c += bb[11] * u2.w; c += bb[12] * u3.x; c += bb[13] * u3.y; c += bb[14] * u3.z; c += bb[15] * u3.w;
    const f32x2 xs = {x.y, x.x};
    return x * lr + (xs * (f32x2){-li, li} + (a + c));
}
DI void s5_stage_u(const bf16* U  , size_t tok0, LAS bf16* UW, int lane) {
#pragma unroll
    for (int i = 0; i < 4; ++i) { const int q = lane + 64 * i, tl = q >> 1, hf = q & 1; *(LAS v4u*)(UW + tl * 16 + hf * 8) = *(const v4u*)(U + (tok0 + tl) * CD_N + hf * 8); }
    asm volatile("s_waitcnt vmcnt(0) lgkmcnt(0)" ::: "memory");
}
DI void s5_load_u(const LAS bf16* UW, int tl, float (&u)[16]) {
    const v4u a = *(const LAS v4u*)(UW + tl * 16), b = *(const LAS v4u*)(UW + tl * 16 + 8);
    u[0] = bflo(a.x); u[1] = bfhi(a.x); u[2] = bflo(a.y); u[3] = bfhi(a.y); u[4] = bflo(a.z); u[5] = bfhi(a.z); u[6] = bflo(a.w); u[7] = bfhi(a.w);
    u[8] = bflo(b.x); u[9] = bfhi(b.x); u[10] = bflo(b.y); u[11] = bfhi(b.y); u[12] = bflo(b.z); u[13] = bfhi(b.z); u[14] = bflo(b.w); u[15] = bfhi(b.w);
}
DI void s5_passA(const Ctx& C, const S5P& P, const bf16* PROJ, f32x2* END) {
    LAS float* UF = (LAS float*)(C.lds + C.wave * 8192);
    for (int item = C.gw; item < BATCH * SNSEG * 64 * 2; item += C.ngw) {
        const int dir = item & 1, g = (item >> 1) & 63, seg = (item >> 7) & (SNSEG - 1), b = item >> 13; const int lane = C.lane; const size_t tok0 = (size_t)b * SEQ + seg * SSEG;
        float lr, li; f32x2 bb[16]; s5_disc(P, dir, g, lane, lr, li, bb);
#pragma unroll
        for (int i = 0; i < 4; ++i) { const int q = lane + 64 * i, tl = q >> 1, hf = q & 1; const v4u v = *(const v4u*)(PROJ + (tok0 + tl) * CD_N + 3072 + g * 16 + hf * 8);
            *(LAS f32x4*)(UF + tl * 16 + hf * 8) = (f32x4){bflo(v.x), bfhi(v.x), bflo(v.y), bfhi(v.y)}; *(LAS f32x4*)(UF + tl * 16 + hf * 8 + 4) = (f32x4){bflo(v.z), bfhi(v.z), bflo(v.w), bfhi(v.w)}; }
        f32x2 x = {0.f, 0.f};
#pragma unroll 2
        for (int i = 0; i < SSEG; ++i) { const int tl = dir ? SSEG - 1 - i : i; x = s5_step((const LAS f32x4*)(UF + tl * 16), bb, lr, li, x); }
        const int sl = dir ? SNSEG - 1 - seg : seg;
        END[((size_t)((b * 2 + dir) * SNSEG + sl)) * 4096 + g * 64 + lane] = x;
        asm volatile("s_waitcnt lgkmcnt(0)" ::: "memory");
    }
}
DI void s5_gen_G(const Ctx& C, const S5P& P, bf16* G) {
    for (int item = blockIdx.x; item < 128; item += gridDim.x) { const int dir = item & 1, g = item >> 1, p = C.lane;
        float lr, li; f32x2 bb[16]; s5_disc(P, dir, g, p, lr, li, bb);
        const int j0 = 16 * C.wave; int e0 = dir ? j0 : 127 - (j0 + 15);
        float pr = 1.f, pi = 0.f; { float br = lr, bi = li; int n = e0;
#pragma unroll
            for (int it = 0; it < 7; ++it) { if (n & 1) { const float t = pr * br - pi * bi; pi = pr * bi + pi * br; pr = t; } const float t2 = br * br - bi * bi; bi = 2.f * br * bi; br = t2; n >>= 1; } }
        bf16* gre = G + ((size_t)item * 128 + p) * 2048; bf16* gim = gre + (size_t)64 * 2048;
#pragma unroll 1
        for (int s = 0; s < 16; ++s) { const int j = dir ? j0 + s : j0 + 15 - s;
            float re[16], im[16];
#pragma unroll
            for (int c = 0; c < 16; ++c) { re[c] = pr * bb[c].x - pi * bb[c].y; im[c] = pr * bb[c].y + pi * bb[c].x; }
            v4u o; o.x = pk2(re[0], re[1]); o.y = pk2(re[2], re[3]); o.z = pk2(re[4], re[5]); o.w = pk2(re[6], re[7]); *(v4u*)(gre + j * 16) = o;
            o.x = pk2(re[8], re[9]); o.y = pk2(re[10], re[11]); o.z = pk2(re[12], re[13]); o.w = pk2(re[14], re[15]); *(v4u*)(gre + j * 16 + 8) = o;
            o.x = pk2(im[0], im[1]); o.y = pk2(im[2], im[3]); o.z = pk2(im[4], im[5]); o.w = pk2(im[6], im[7]); *(v4u*)(gim + j * 16) = o;
            o.x = pk2(im[8], im[9]); o.y = pk2(im[10], im[11]); o.z = pk2(im[12], im[13]); o.w = pk2(im[14], im[15]); *(v4u*)(gim + j * 16 + 8) = o;
            const float t = pr * lr - pi * li; pi = pr * li + pi * lr; pr = t; }
    }
}
DI void s5_end_gemm(const Ctx& C, const bf16* PROJ, const bf16* G, float* ENDF) {
    const int lane = C.lane, fr = lane & 15, fq = lane >> 4, w = C.wave;
    for (int item = blockIdx.x; item < 256; item += gridDim.x) { const int nh = item & 1, gd = item >> 1, dir = gd & 1, g = gd >> 1;
        const int ar = 16 * w + fr, ab = ar >> 6, as = ar & 63;
        const bf16* ap = PROJ + ((size_t)g * T + ab * SEQ + as * SSEG) * 16 + 8 * fq;
        const bf16* bp = G + ((size_t)gd * 128 + nh * 64 + fr) * 2048 + 8 * fq;
        f32x4 acc[4];
#pragma unroll
        for (int ct = 0; ct < 4; ++ct) acc[ct] = (f32x4){0.f, 0.f, 0.f, 0.f};
#pragma unroll 4
        for (int ks = 0; ks < 64; ++ks) { const bf16x8 a = *(const bf16x8*)(ap + 32 * ks);
#pragma unroll
            for (int ct = 0; ct < 4; ++ct) acc[ct] = mfma16(a, *(const bf16x8*)(bp + (size_t)ct * 16 * 2048 + 32 * ks), acc[ct]); }
#pragma unroll
        for (int ct = 0; ct < 4; ++ct)
#pragma unroll
            for (int j = 0; j < 4; ++j) { const int r = 16 * w + fq * 4 + j, b = r >> 6, s = r & 63, sl = dir ? SNSEG - 1 - s : s;
                ENDF[((size_t)((b * 2 + dir) * SNSEG + sl)) * 8192 + g * 128 + nh * 64 + ct * 16 + fr] = acc[ct][j]; }
    }
}
DI void s5_passB(const Ctx& C, const S5P& P, const f32x2* END, f32x2* CARR) {
    const int gt = blockIdx.x * NTHR + C.tid;
    if (gt < BATCH * 2 * 4096) { const int p = gt & 63, g = (gt >> 6) & 63, bd = gt >> 12, dir = bd & 1;
        const float dt = expf(P.log_dt[dir * 64 + g]); const float are = P.a_re[(dir * 64 + g) * 64 + p], aim = P.a_im[(dir * 64 + g) * 64 + p];
        const float mag = expf(dt * are); float lr = mag * cosf(dt * aim), li = mag * sinf(dt * aim);
#pragma unroll
        for (int i = 0; i < 7; ++i) { const float nr = lr * lr - li * li, ni = 2.0f * lr * li; lr = nr; li = ni; }
        float cr = 0.f, ci = 0.f;
        for (int sl = 0; sl < SNSEG; ++sl) { const size_t idx = ((size_t)(bd * SNSEG + sl)) * 4096 + (gt & 4095); CARR[idx] = (f32x2){cr, ci}; const f32x2 e = END[idx];
            const float nr = lr * cr - li * ci + e.x, ni = lr * ci + li * cr + e.y; cr = nr; ci = ni; }
    }
}
DI float s5_reduce16(float (&v)[16], int lane) {
    float a[8];
#pragma unroll
    for (int i = 0; i < 8; ++i) { const bool hi = (lane & 32) != 0; const float keep = hi ? v[i + 8] : v[i], send = hi ? v[i] : v[i + 8]; a[i] = keep + __shfl_xor(send, 32); }
    float b[4];
#pragma unroll
    for (int i = 0; i < 4; ++i) { const bool hi = (lane & 16) != 0; const float keep = hi ? a[i + 4] : a[i], send = hi ? a[i] : a[i + 4]; b[i] = keep + __shfl_xor(send, 16); }
    float c[2];
#pragma unroll
    for (int i = 0; i < 2; ++i) { const bool hi = (lane & 8) != 0; const float keep = hi ? b[i + 2] : b[i], send = hi ? b[i] : b[i + 2]; c[i] = keep + __shfl_xor(send, 8); }
    const bool hi = (lane & 4) != 0; const float keep = hi ? c[1] : c[0], send = hi ? c[0] : c[1]; float d = keep + __shfl_xor(send, 4);
    d += __shfl_xor(d, 1); d += __shfl_xor(d, 2);
    return d;
}
template <int DIRN, int SUB> DI void s5_subtile(const LAS float* UF, LAS bf16* XT, float lr, float li, const f32x2 (&bb)[16], f32x2& x,
                                                const bf16x8 (&bfr)[4], f32x4& acc0, f32x4& acc1, int lane) {
#pragma unroll 1
    for (int i = 0; i < 32; ++i) { const int r = DIRN ? 31 - i : i;
        x = s5_step((const LAS f32x4*)(UF + (32 * SUB + r) * 16), bb, lr, li, x);
        const unsigned pkd = pk2(x.x, x.y); XT[r * 136 + lane] = (bf16)(pkd & 0xffffu); XT[r * 136 + 64 + lane] = (bf16)(pkd >> 16); }
#pragma unroll
    for (int ks = 0; ks < 4; ++ks) { const bf16x8 a0 = *(const LAS bf16x8*)(XT + (lane & 15) * 136 + 32 * ks + 8 * (lane >> 4)), a1 = *(const LAS bf16x8*)(XT + (16 + (lane & 15)) * 136 + 32 * ks + 8 * (lane >> 4));
        acc0 = mfma16(a0, bfr[ks], acc0); acc1 = mfma16(a1, bfr[ks], acc1); }
}
template <int DIRN> DI void s5_dir(const S5P& P, const f32x2* END, const LAS float* UF, LAS bf16* XT, int b, int seg, int g, const bf16x8 (&bfr)[4], f32x4 (&acc)[8], int lane) {
    float lr, li; f32x2 bb[16]; s5_disc(P, DIRN, g, lane, lr, li, bb);
    const int sl = DIRN ? SNSEG - 1 - seg : seg; float xr = 0.f, xi = 0.f;
    { float Lr = lr, Li = li;
#pragma unroll
        for (int i = 0; i < 7; ++i) { const float nr = Lr * Lr - Li * Li, ni = 2.0f * Lr * Li; Lr = nr; Li = ni; }
#pragma unroll 8
        for (int j = 0; j < sl; ++j) { const float* ep = (const float*)END + ((size_t)((b * 2 + DIRN) * SNSEG + j)) * 8192 + g * 128 + lane; const f32x2 e = {ep[0], ep[64]}; const float nr = Lr * xr - Li * xi + e.x, ni = Lr * xi + Li * xr + e.y; xr = nr; xi = ni; } }
    f32x2 x = {xr, xi};
    if (DIRN == 0) { s5_subtile<0, 0>(UF, XT, lr, li, bb, x, bfr, acc[0], acc[1], lane); s5_subtile<0, 1>(UF, XT, lr, li, bb, x, bfr, acc[2], acc[3], lane);
                     s5_subtile<0, 2>(UF, XT, lr, li, bb, x, bfr, acc[4], acc[5], lane); s5_subtile<0, 3>(UF, XT, lr, li, bb, x, bfr, acc[6], acc[7], lane); }
    else {           s5_subtile<1, 3>(UF, XT, lr, li, bb, x, bfr, acc[6], acc[7], lane); s5_subtile<1, 2>(UF, XT, lr, li, bb, x, bfr, acc[4], acc[5], lane);
                     s5_subtile<1, 1>(UF, XT, lr, li, bb, x, bfr, acc[2], acc[3], lane); s5_subtile<1, 0>(UF, XT, lr, li, bb, x, bfr, acc[0], acc[1], lane); }
}
DI void s5_passC(const Ctx& C, const S5P& P, const bf16* PROJ, const f32x2* END, bf16* YG  , int item_lo, int item_hi) {
    LAS float* UF = (LAS float*)(C.lds + C.wave * 16896); LAS bf16* XT = (LAS bf16*)(C.lds + C.wave * 16896 + 8192);
    for (int item = item_lo + C.gw; item < item_hi; item += C.ngw) {
        int lane = C.lane; asm volatile("" : "+v"(lane));
        const int g = item & 63, seg = (item >> 6) & (SNSEG - 1), b = item >> 12; const size_t tok0 = (size_t)b * SEQ + seg * SSEG;
#pragma unroll
        for (int i = 0; i < 4; ++i) { const int q = lane + 64 * i, tl = q >> 1, hf = q & 1; const v4u v = *(const v4u*)(PROJ + ((size_t)g * T + tok0 + tl) * 16 + hf * 8);
            *(LAS f32x4*)(UF + tl * 16 + hf * 8) = (f32x4){bflo(v.x), bfhi(v.x), bflo(v.y), bfhi(v.y)}; *(LAS f32x4*)(UF + tl * 16 + hf * 8 + 4) = (f32x4){bflo(v.z), bfhi(v.z), bflo(v.w), bfhi(v.w)}; }
        bf16x8 bfr[4];
#pragma unroll
        for (int ks = 0; ks < 4; ++ks) { const float* src = (ks < 2 ? P.c_re : P.c_im) + (size_t)(g * 16 + (lane & 15)) * 64 + 32 * (ks & 1) + 8 * (lane >> 4); const f32x4 a = *(const f32x4*)src, bq = *(const f32x4*)(src + 4);
            const float sg = ks < 2 ? 1.0f : -1.0f; v4u w; w.x = pk2(sg * a.x, sg * a.y); w.y = pk2(sg * a.z, sg * a.w); w.z = pk2(sg * bq.x, sg * bq.y); w.w = pk2(sg * bq.z, sg * bq.w); bfr[ks] = __builtin_bit_cast(bf16x8, w); }
        f32x4 acc[8];
#pragma unroll
        for (int r = 0; r < 8; ++r) acc[r] = (f32x4){0.f, 0.f, 0.f, 0.f};
        s5_dir<0>(P, END, UF, XT, b, seg, g, bfr, acc, lane);
        s5_dir<1>(P, END, UF, XT, b, seg, g, bfr, acc, lane);
        const float dv = P.d[g * 16 + (lane & 15)];
#pragma unroll
        for (int r = 0; r < 8; ++r)
#pragma unroll
            for (int j = 0; j < 4; ++j) { const int t = 16 * r + (lane >> 4) * 4 + j; const float y = acc[r][j] + dv * UF[t * 16 + (lane & 15)]; YG[(tok0 + t) * 1024 + g * 16 + (lane & 15)] = f2bf(gelu_tanh(y)); }
        asm volatile("s_waitcnt lgkmcnt(0)" ::: "memory");
    }
}
DI void zero_half(const Ctx& C, bf16* Y  ) { for (int it = C.gw; it < T; it += C.ngw) { v4u z = {0u, 0u, 0u, 0u}; *(v4u*)(Y + (size_t)it * D + 16 * C.lane) = z; *(v4u*)(Y + (size_t)it * D + 16 * C.lane + 8) = z; } }
struct Args { const float* in[32]; float* out; unsigned char* ws; int ph_lo, ph_hi; };
constexpr int N_PHASES = 3 + 5 + 2 + 3 + 5 + 2 + 1;

__global__ void __launch_bounds__(NTHR, 2) hybrid_fwd(Args args) {
    extern __shared__ __attribute__((aligned(16))) unsigned char lds_raw[];
    cg::grid_group grid = cg::this_grid();
    LAS unsigned char* const lds0 = (LAS unsigned char*)lds_raw;
    volatile LAS unsigned* xst = (volatile LAS unsigned*)(lds0 + LDS_BYTES - 16);
    if (threadIdx.x == 0) { xst[0] = 0u; xst[1] = 0u; }
    unsigned* barw = (unsigned*)args.ws;
    if (blockIdx.x == 0) for (int i = threadIdx.x; i < XCD_BAR_WORDS; i += NTHR) barw[i] = 0u;
    __syncthreads();
    XcdBarrier xbar; xbar.bar = barw; xbar.x = 0u; xbar.st = xst;
    const int lo = args.ph_lo, hi = args.ph_hi; int ph = 0;
#define X outl
#define GATES ((float*)(wsl + WS_GATES))
#define AGG ((f32x2*)(wsl + WS_AGG))
#define WGT ((bf16*)(wsl + WS_WGT))
#define W_MIN ((bf16*)(wsl + WS_MIN))
#define W_MOUT ((bf16*)(wsl + WS_MOUT))
#define W_GLU ((bf16*)(wsl + WS_GLU))
#define W_LRU ((bf16*)(wsl + WS_LRUW))
#define HN ((bf16*)(wsl + WS_HN))
#define YMIX ((bf16*)(wsl + WS_YMIX))
#define BIG ((bf16*)(wsl + WS_BIG))
#define HF ((bf16*)(wsl + WS_HF))
#define HB ((bf16*)(wsl + WS_HB))
#define GP (wsl + WS_GP)
#define W_GU ((bf16*)(wsl + WS_GU) + (size_t)f * (2 * FF) * D)
#define W_DN ((bf16*)(wsl + WS_DN) + (size_t)f * D * FF)
#define ROWSS ((pg8::rowss_t*)(wsl + WS_CAR))
#define ROWSS_ (ROWSS + (size_t)(l == 0 ? 0 : 3) * T)
#define LA ((bf16*)GP)
#define BV ((bf16*)(GP + 64 * MiB))
#define CUM ((float*)GP)
#define SEND ((f32x2*)(GP + 64 * MiB))
#define YG ((bf16*)(GP + 80 * MiB))
#define MKP const S5P P{args.in[21], args.in[22], args.in[23], args.in[24], args.in[25], args.in[26], args.in[27], args.in[28]}
#define PH_BEGIN if (ph >= lo && ph < hi) { Ctx C; { int t_ = threadIdx.x; asm volatile("" : "+v"(t_)); C.lds = lds0; C.tid = t_; C.lane = t_ & 63; C.wave = __builtin_amdgcn_readfirstlane(t_ >> 6); C.gw = blockIdx.x * NWAVES + C.wave; C.ngw = gridDim.x * NWAVES; } unsigned char* wsl = args.ws; float* outl = args.out; asm volatile("" : "+s"(wsl), "+s"(outl));
#define PH_END } if (ph >= lo && ph + 1 < hi) { if (ph == 0) { grid.sync(); xbar = xcd_barrier_post(barw, xst); } else xcd_barrier(xbar); } ++ph;
    for (int st = 0; st < 6; ++st) {
        const int l = st / 3, k = st % 3;
        if (k == 1 && (DBG_SKIP & (1 << l))) { ph += 5; continue; }
        if (k != 1) {
            const int f = k >> 1;
            if (st == 0 || st == 3) {
            PH_BEGIN
                REP(1) {
                if (st == 0) { for (int i = blockIdx.x * NTHR + C.tid; i < 6 * T; i += gridDim.x * NTHR) ROWSS[i] = 0ull; }
                if (k == 0) {
                    if (l == 0) { conv_gu(C, args.in[2], (bf16*)(wsl + WS_GU)); conv_gu(C, args.in[6], (bf16*)(wsl + WS_GU) + (size_t)(2 * FF) * D);
                        conv_plain(C, args.in[3], D, FF, D, 1 << 30, 0, (bf16*)(wsl + WS_DN)); conv_plain(C, args.in[7], D, FF, D, 1 << 30, 0, (bf16*)(wsl + WS_DN) + (size_t)D * FF);
                        conv_plain(C, args.in[8], AB_LD, D, AB_N, 1 << 30, 0, W_MIN); conv_plain(C, args.in[16], D, D, D, 1 << 30, 0, W_MOUT); conv_small(C, args.in[8], AB_LD, AB_N, 16, WGT);
                        for (int m = 0; m < 32; ++m) conv_plain(C, args.in[11] + (size_t)m * 128 * 128, 128, 128, 128, 1 << 30, 0, W_LRU + (size_t)m * 128 * 128); }
                    else { conv_gu(C, args.in[6] + (size_t)D * 2 * FF, (bf16*)(wsl + WS_GU) + (size_t)(2 * FF) * D); conv_plain(C, args.in[7] + (size_t)FF * D, D, FF, D, 1 << 30, 0, (bf16*)(wsl + WS_DN) + (size_t)D * FF);
                        conv_plain(C, args.in[30], D, D, D, 1 << 30, 0, W_MOUT); }
                }
                if (st == 0) rms_rows_bf16(C, args.in[0], args.in[1], HN); }
            PH_END
            }
            PH_BEGIN REP(2) { pg8::Gemm g{HN, W_GU, T, 2 * FF, D}; pg8::StaticOrder S; S.init(T, 2 * FF, gridDim.x, blockIdx.x); pg8::EpiSwiglu E{BIG, FF, st == 0 ? nullptr : ROWSS + (size_t)(st == 2 ? 1 : st == 3 ? 2 : 4) * T};
                pg8::gemm_phase<pg8::EpiSwiglu, pg8::StaticOrder, true, true>(C.lds, g, S, E); }
            PH_END
            PH_BEGIN { pg8::Gemm g{BIG, W_DN, T, D, FF}; pg8::StaticOrder S; S.init(T, D, gridDim.x, blockIdx.x); pg8::EpiResid E{st == 0 ? args.in[0] : X, X, D, 0.5f, st == 5 ? nullptr : HN, st == 0 ? args.in[4] : st == 2 ? args.in[1] + D : args.in[4] + D, ROWSS + (size_t)(st == 0 ? 0 : st == 2 ? 2 : 3) * T};
                pg8::gemm_phase<pg8::EpiResid, pg8::StaticOrder, false, true>(C.lds, g, S, E); }
            PH_END
        } else if (l == 0) {
            PH_BEGIN REP(256) { gate_gemm<1>(C, HN, WGT, args.in[14], GATES, ROWSS_); asm volatile("s_waitcnt vmcnt(0)" ::: "memory"); __syncthreads();
                pg8::Gemm g{HN, W_MIN, T, AB_N, D}; pg8::StaticOrder S; S.init(T, AB_N, gridDim.x, blockIdx.x); pg8::EpiStoreBf16 E{BIG, AB_N, ROWSS_, nullptr, 0};
                pg8::gemm_phase<pg8::EpiStoreBf16, pg8::StaticOrder, true, true>(C.lds, g, S, E); }
            PH_END
            PH_BEGIN REP(1024) mlstm_pre(C, BIG, GATES, (f32x4*)HN, HN + 2 * MiB); PH_END
            PH_BEGIN
                REP(8192) {
                if (blockIdx.x < 128) mlstm_phase<false>(C, BIG, (const f32x4*)HN, HN + 2 * MiB, HF, HB, xbar);
                else { Ctx C2 = C; C2.gw = (blockIdx.x - 128) * NWAVES + C.wave; C2.ngw = (gridDim.x - 128) * NWAVES;
                    REP(16384) lru_gate_phase(C2, BIG, args.in[9], args.in[10], W_LRU, args.in[12], args.in[13], LA, BV); half_barrier(barw + 16, gridDim.x - 128);
                    REP(32768) lru_pass1(C2, LA, BV, AGG); half_barrier(barw + 80, gridDim.x - 128);
                    REP(65536) lru_pass3(C2, LA, BV, AGG, BIG, nullptr, YMIX);
                    __syncthreads();
                    conv_gu(C2, args.in[2] + (size_t)D * 2 * FF, (bf16*)(wsl + WS_GU)); conv_plain(C2, args.in[3] + (size_t)FF * D, D, FF, D, 1 << 30, 0, (bf16*)(wsl + WS_DN));
                    conv_plain(C2, args.in[17], CD_LD, D, CD_N, 3072, 32, W_MIN); conv_small(C2, args.in[17], CD_LD, 3072, 32, WGT); conv_plain(C2, args.in[29], 1024, 1024, 1024, 1 << 30, 0, W_GLU); } }
            PH_END
            PH_BEGIN REP(128) hnorm_phase<0>(C, HF, HB, args.in[15], BIG + 5120, AB_N, YMIX + 1024); PH_END
            PH_BEGIN { pg8::Gemm g{YMIX, W_MOUT, T, D, D}; pg8::StaticOrder S; S.init(T, D, gridDim.x, blockIdx.x); pg8::EpiResid E{X, X, D, 1.0f, HN, args.in[5], ROWSS_ + (size_t)1 * T};
                pg8::gemm_phase<pg8::EpiResid, pg8::StaticOrder, false, true>(C.lds, g, S, E); }
            PH_END
        } else {
            PH_BEGIN REP(256) { { MKP; s5_gen_G(C, P, HF); }
                gate_gemm<2>(C, HN, WGT, nullptr, GATES, ROWSS_); asm volatile("s_waitcnt vmcnt(0)" ::: "memory"); __syncthreads();
                pg8::Gemm g{HN, W_MIN, T, CD_N, D}; pg8::StaticOrder S; S.init(T, CD_N, gridDim.x, blockIdx.x); pg8::EpiStoreBf16 E{BIG, CD_N, ROWSS_, YMIX, 3072};
                pg8::gemm_phase<pg8::EpiStoreBf16, pg8::StaticOrder, true, true>(C.lds, g, S, E); }
            PH_END
            PH_BEGIN MKP; REP(64) { gla_cum_phase(C, GATES, args.in[18], args.in[19], CUM, BIG, HN, BIG + 64 * MiB, BIG + 80 * MiB); __syncthreads(); } REP(32) s5_end_gemm(C, YMIX, HF, (float*)SEND); PH_END
            PH_BEGIN
                MKP;
                REP(4096) {
                constexpr int S5_SPLIT = 6144;
                if (blockIdx.x < 128) { gla_phase(C, BIG, CUM, HN, BIG + 64 * MiB, BIG + 80 * MiB, HF, HB); __syncthreads();
                    Ctx C2 = C; C2.ngw = 128 * NWAVES; s5_passC(C2, P, YMIX, SEND, YG, S5_SPLIT, BATCH * SNSEG * 64); }
                else { Ctx C2 = C; C2.gw = (blockIdx.x - 128) * NWAVES + C.wave; C2.ngw = (gridDim.x - 128) * NWAVES; s5_passC(C2, P, YMIX, SEND, YG, 0, S5_SPLIT); } }
            PH_END
            PH_BEGIN REP(2048) { hnorm_phase<1>(C, HF, HB, args.in[20], BIG + 2048, CD_N, YMIX); asm volatile("s_waitcnt vmcnt(0)" ::: "memory"); __syncthreads();
                pg8::Gemm g{YG, W_GLU, T, 1024, 1024}; pg8::StaticOrder S; S.init(T, 1024, gridDim.x, blockIdx.x); pg8::EpiGlu E{YG, 1024, YMIX + 1024, D};
                pg8::gemm_phase<pg8::EpiGlu, pg8::StaticOrder, true, true>(C.lds, g, S, E); }
            PH_END
            PH_BEGIN { pg8::Gemm g{YMIX, W_MOUT, T, D, D}; pg8::StaticOrder S; S.init(T, D, gridDim.x, blockIdx.x); pg8::EpiResid E{X, X, D, 1.0f, HN, args.in[5] + D, ROWSS_ + (size_t)1 * T};
                pg8::gemm_phase<pg8::EpiResid, pg8::StaticOrder, false, true>(C.lds, g, S, E); }
            PH_END
        }
    }
    for (int xs_ = 0; xs_ < DBG_XSYNC; ++xs_) xcd_barrier(xbar);
    PH_BEGIN REP(512) rms_rows_f32(C, X, args.in[31]); PH_END
#undef PH_BEGIN
#undef PH_END
}
#undef X
#undef GATES
#undef AGG
#undef WGT
#undef W_MIN
#undef W_MOUT
#undef W_GLU
#undef W_LRU
#undef HN
#undef YMIX
#undef BIG
#undef HF
#undef HB
#undef GP
#undef W_GU
#undef W_DN
#undef ROWSS
#undef ROWSS_
#undef LA
#undef BV
#undef CUM
#undef SEND
#undef YG
#undef MKP

#ifndef MULTI_LAUNCH
#define MULTI_LAUNCH 0
#endif
extern "C" void kernel_launch(void* const* d_in, const int* in_sizes, int n_in, void* d_out, int out_size, void* d_ws, size_t ws_size, hipStream_t stream) {
    static int grid = 0;
    if (grid == 0) {
        if (n_in != 32 || out_size != T * D || ws_size < WS_END) { fprintf(stderr, "kernel_launch: unexpected shapes (n_in %d out %d ws %zu)\n", n_in, out_size, ws_size); grid = -1; return; }
        int dev = 0, cus = 0, per_cu = 0;
        (void)hipGetDevice(&dev); (void)hipDeviceGetAttribute(&cus, hipDeviceAttributeMultiprocessorCount, dev);
        if (hipFuncSetAttribute((const void*)hybrid_fwd, hipFuncAttributeMaxDynamicSharedMemorySize, LDS_BYTES) != hipSuccess) { fprintf(stderr, "kernel_launch: hipFuncSetAttribute failed\n"); grid = -1; return; }
        if (hipOccupancyMaxActiveBlocksPerMultiprocessor(&per_cu, (const void*)hybrid_fwd, NTHR, LDS_BYTES) != hipSuccess || per_cu < 1) { fprintf(stderr, "kernel_launch: occupancy query gave %d\n", per_cu); per_cu = 1; }
        (void)hipGetLastError();
        grid = cus * 1;
    }
    if (grid < 0) return;
    Args a{};
    for (int i = 0; i < 32; ++i) a.in[i] = (const float*)d_in[i];
    a.out = (float*)d_out; a.ws = (unsigned char*)d_ws;
#if MULTI_LAUNCH
    for (int p = 0; p < N_PHASES; ++p) { a.ph_lo = p; a.ph_hi = p + 1; hipLaunchKernelGGL(hybrid_fwd, dim3(grid), dim3(NTHR), LDS_BYTES, stream, a); }
#else
    a.ph_lo = 0; a.ph_hi = N_PHASES;
    void* kargs[] = {&a};
    const hipError_t e = hipLaunchCooperativeKernel((const void*)hybrid_fwd, dim3(grid), dim3(NTHR), kargs, LDS_BYTES, stream);
    if (e != hipSuccess) fprintf(stderr, "kernel_launch: cooperative launch failed: %s (grid %d)\n", hipGetErrorString(e), grid);
#endif
}
```
